# Optimizing an MI355X kernel written in HIP

```python
import math
import jax, jax.numpy as jnp
from jax import lax
import numpy as np

D_MODEL = 1024
BATCH = 4
SEQ = 4096
DEPTH = 4

CHUNK = 64
N_MEM = 256
EPS = 1e-6
NEG_INF = -1e30
N_NORMS = 6

BRANCH_DIM = D_MODEL // 2
N_BRANCH = 3

HEAD_DIM = 64
A_Q_HEADS = BRANCH_DIM // HEAD_DIM
A_KV_HEADS = 2
A_GROUP = A_Q_HEADS // A_KV_HEADS
A_Q_DIM = A_Q_HEADS * HEAD_DIM
A_KV_DIM = A_KV_HEADS * HEAD_DIM
WINDOW = 128
WINDOW_CHUNKS = WINDOW // CHUNK
ATT_BLOCK = 128

SGU_CHUNK = 128
SGU_GROUPS = 4
SGU_DIM = BRANCH_DIM
SGU_GROUP_DIM = SGU_DIM // SGU_GROUPS

POOL_WINDOWS = (2, 4, 8, 16)
POOL_GROUPS = 4
POOL_DIM = BRANCH_DIM
POOL_GROUP_DIM = POOL_DIM // POOL_GROUPS

IN_SIZES = (A_Q_DIM, A_KV_DIM, A_KV_DIM, SGU_DIM, SGU_DIM, POOL_DIM, N_BRANCH * D_MODEL)
IN_DIM = A_Q_DIM + 2 * A_KV_DIM + 2 * SGU_DIM + POOL_DIM + N_BRANCH * D_MODEL

MEM_HEADS = 4
MEM_HEAD_DIM = 128
MEM_DIM = MEM_HEADS * MEM_HEAD_DIM

D_FF = 4 * D_MODEL

kernel_name = "hybrid_gated_parallel_streaming_trunk"


def rmsnorm(x, g):
    xf = x.astype(jnp.float32)
    y = xf * lax.rsqrt(jnp.mean(xf * xf, axis=-1, keepdims=True) + EPS)
    return (y * g.astype(jnp.float32)).astype(x.dtype)


def split_columns(proj):
    parts, start = [], 0
    for size in IN_SIZES:
        parts.append(proj[..., start:start + size])
        start += size
    return parts


def window_sink_attention(q, k, v, sinks):
    B, S, _ = q.shape
    nb = S // ATT_BLOCK
    qb = q.reshape(B, nb, ATT_BLOCK, A_KV_HEADS, A_GROUP, HEAD_DIM)

    def band(t):
        t = t.reshape(B, S, A_KV_HEADS, HEAD_DIM)
        t = jnp.pad(t, ((0, 0), (ATT_BLOCK, 0), (0, 0), (0, 0)))
        t = t.reshape(B, nb + 1, ATT_BLOCK, A_KV_HEADS, HEAD_DIM)
        return jnp.concatenate([t[:, :-1], t[:, 1:]], axis=2)

    kb, vb = band(k), band(v)
    s = jnp.einsum('bnqhgd,bnkhd->bnhgqk', qb, kb).astype(jnp.float32) * (1.0 / math.sqrt(HEAD_DIM))

    blk = jnp.arange(nb)[:, None, None]
    qpos = blk * ATT_BLOCK + jnp.arange(ATT_BLOCK)[None, :, None]
    kpos = (blk - 1) * ATT_BLOCK + jnp.arange(2 * ATT_BLOCK)[None, None, :]
    qc, kc = qpos // CHUNK, kpos // CHUNK
    valid = (kpos >= 0) & (kc <= qc) & (kc >= qc - WINDOW_CHUNKS)
    s = jnp.where(valid[None, :, None, None], s, NEG_INF)

    sink = sinks.astype(jnp.float32).reshape(A_KV_HEADS, A_GROUP)[None, None, :, :, None, None]
    m = jnp.maximum(jnp.max(s, axis=-1, keepdims=True), sink)
    p = jnp.exp(s - m)
    p = p / (jnp.sum(p, axis=-1, keepdims=True) + jnp.exp(sink - m))
    o = jnp.einsum('bnhgqk,bnkhd->bnqhgd', p.astype(v.dtype), vb)
    return o.reshape(B, S, A_Q_DIM)


def spatial_gating(u, v, g_sgu, w_s, b_s):
    B, S, _ = u.shape
    nc = S // SGU_CHUNK
    u = jax.nn.gelu(u)
    v = rmsnorm(jax.nn.gelu(v), g_sgu)
    vb = v.reshape(B, nc, SGU_CHUNK, SGU_GROUPS, SGU_GROUP_DIM)
    pc = jnp.arange(SGU_CHUNK) // CHUNK
    mask = pc[None, :] <= pc[:, None]
    w = jnp.where(mask[None], w_s, 0.0).astype(v.dtype)
    sp = jnp.einsum('gij,bnjgc->bnigc', w, vb) + b_s.T[:, :, None].astype(v.dtype)
    return u * sp.reshape(B, S, SGU_DIM)


def multiscale_pool(c, w_pool, pool_scale):
    B, S, _ = c.shape
    cs = jnp.cumsum(c.astype(jnp.float32), axis=1)
    t = jnp.arange(S)
    outs = []
    for gi, w in enumerate(POOL_WINDOWS):
        cg = cs[..., gi * POOL_GROUP_DIM:(gi + 1) * POOL_GROUP_DIM]
        lag = jnp.pad(cg, ((0, 0), (w, 0), (0, 0)))[:, :S]
        cnt = jnp.minimum(t + 1, w).astype(jnp.float32)[None, :, None]
        outs.append((cg - lag) / cnt)
    pooled = jnp.concatenate(outs, axis=-1).astype(c.dtype) - c
    pooled = pooled.reshape(B, S, POOL_GROUPS, POOL_GROUP_DIM)
    mixed = jnp.einsum('bsgc,gcd->bsgd', pooled, w_pool).reshape(B, S, POOL_DIM)
    return mixed * pool_scale


def memory_attention(h, mem_n, w_q, w_kv, w_o):
    B, S, _ = h.shape
    q = (h @ w_q).reshape(B, S, MEM_HEADS, MEM_HEAD_DIM)
    kv = mem_n @ w_kv
    k = kv[..., :MEM_DIM].reshape(B, N_MEM, MEM_HEADS, MEM_HEAD_DIM)
    v = kv[..., MEM_DIM:].reshape(B, N_MEM, MEM_HEADS, MEM_HEAD_DIM)
    s = jnp.einsum('bshd,bmhd->bhsm', q, k).astype(jnp.float32) * (1.0 / math.sqrt(MEM_HEAD_DIM))
    p = jax.nn.softmax(s, axis=-1).astype(h.dtype)
    o = jnp.einsum('bhsm,bmhd->bshd', p, v).reshape(B, S, MEM_DIM)
    return o @ w_o


def setup_inputs(seed: int = 0) -> dict:
    key = jax.random.key(seed)
    ks = jax.random.split(key, 20)
    f32 = jnp.float32

    def dense(k, shape, fan_in):
        return jax.random.normal(k, shape, f32) * (fan_in ** -0.5)

    return {
        "x": jax.random.normal(ks[0], (BATCH, SEQ, D_MODEL), f32),
        "mem": jax.random.normal(ks[1], (BATCH, N_MEM, D_MODEL), f32),
        "g_norm": 1.0 + 0.1 * jax.random.normal(ks[2], (DEPTH, N_NORMS, D_MODEL), f32),
        "g_mem": 1.0 + 0.1 * jax.random.normal(ks[3], (DEPTH, D_MODEL), f32),
        "w_in": dense(ks[4], (DEPTH, D_MODEL, IN_DIM), D_MODEL),
        "attn_sinks": 0.5 * jax.random.normal(ks[5], (DEPTH, A_Q_HEADS), f32),
        "w_spatial": dense(ks[6], (DEPTH, SGU_GROUPS, SGU_CHUNK, SGU_CHUNK), SGU_CHUNK),
        "b_spatial": 1.0 + 0.1 * jax.random.normal(ks[7], (DEPTH, SGU_GROUPS, SGU_CHUNK), f32),
        "g_sgu": 1.0 + 0.1 * jax.random.normal(ks[8], (DEPTH, SGU_DIM), f32),
        "w_pool": dense(ks[9], (DEPTH, POOL_GROUPS, POOL_GROUP_DIM, POOL_GROUP_DIM), POOL_GROUP_DIM),
        "pool_scale": 1.0 + 0.1 * jax.random.normal(ks[10], (DEPTH, POOL_DIM), f32),
        "w_branch": dense(ks[11], (DEPTH, N_BRANCH, BRANCH_DIM, D_MODEL), BRANCH_DIM),
        "w_out": dense(ks[12], (DEPTH, D_MODEL, D_MODEL), D_MODEL),
        "w_q_mem": dense(ks[13], (DEPTH, D_MODEL, MEM_DIM), D_MODEL),
        "w_kv_mem": dense(ks[14], (DEPTH, D_MODEL, 2 * MEM_DIM), D_MODEL),
        "w_o_mem": dense(ks[15], (DEPTH, MEM_DIM, D_MODEL), MEM_DIM),
        "w_up": dense(ks[16], (DEPTH, D_MODEL, D_FF), D_MODEL),
        "w_down": dense(ks[17], (DEPTH, D_FF, D_MODEL), D_FF),
    }


def reference(x, mem, g_norm, g_mem, w_in, attn_sinks, w_spatial, b_spatial, g_sgu,
              w_pool, pool_scale, w_branch, w_out, w_q_mem, w_kv_mem, w_o_mem, w_up, w_down):
    B, S, _ = x.shape
    for l in range(DEPTH):
        h = rmsnorm(x, g_norm[l, 0])
        q, k, v, su, sv, pc, gate = split_columns(h @ w_in[l])
        ya = window_sink_attention(q, k, v, attn_sinks[l])
        yb = spatial_gating(su, sv, g_sgu[l], w_spatial[l], b_spatial[l])
        yc = multiscale_pool(pc, w_pool[l], pool_scale[l])
        branches = jnp.stack([ya, yb, yc], axis=2)
        proj = jnp.einsum('bsnc,ncd->bsnd', branches, w_branch[l])
        gates = jax.nn.sigmoid(gate.reshape(B, S, N_BRANCH, D_MODEL))
        merged = jnp.sum(gates * proj, axis=2)
        x = x + rmsnorm(merged @ w_out[l], g_norm[l, 1])
        hm = rmsnorm(x, g_norm[l, 2])
        mem_n = rmsnorm(mem, g_mem[l])
        ym = memory_attention(hm, mem_n, w_q_mem[l], w_kv_mem[l], w_o_mem[l])
        x = x + rmsnorm(ym, g_norm[l, 3])
        hf = rmsnorm(x, g_norm[l, 4])
        yf = jnp.square(jax.nn.relu(hf @ w_up[l])) @ w_down[l]
        x = x + rmsnorm(yf, g_norm[l, 5])
    return x
```

```cpp
#include <hip/hip_runtime.h>
#include <hip/hip_cooperative_groups.h>
#include <cstdio>
#include <cstdint>
namespace cg = cooperative_groups;


typedef unsigned short bf16_t;
typedef short bf16x8 __attribute__((ext_vector_type(8)));
typedef float f32x4 __attribute__((ext_vector_type(4)));
typedef unsigned u32x4 __attribute__((ext_vector_type(4)));
typedef unsigned u32x2 __attribute__((ext_vector_type(2)));
typedef int i32x4 __attribute__((ext_vector_type(4)));
#define DEVFN __device__ __forceinline__

constexpr int T = 16384, D = 1024, SEQ = 4096, DEPTH = 4, IN_DIM = 5376, DFF = 4096, NMEM_ROWS = 1024;
constexpr int COL_K = 512, COL_V = 640, COL_SU = 768, COL_SV = 1280, COL_PC = 1792, COL_GATE = 2304;
constexpr float EPS = 1e-6f;
constexpr int WCOL_IN = 64 * 136, WCOL_UP = WCOL_IN + 4 * 5376;
constexpr int KVLD = DEPTH * 1024;
constexpr size_t W_IN = 0, W_BR = W_IN + (size_t)IN_DIM * D, W_OUT = W_BR + 3ull * D * 512, W_Q = W_OUT + (size_t)D * D,
                 W_O = W_Q + 512ull * D, W_UP = W_O + (size_t)D * 512, W_DN = W_UP + (size_t)DFF * D, W_POOL = W_DN + (size_t)D * DFF,
                 W_TOTAL = W_POOL + 4ull * 128 * 128;

struct Params {
    const float *x, *mem, *g_norm, *g_mem, *w_in, *sinks, *w_sp, *b_sp, *g_sgu, *w_pool, *pool_scale, *w_branch, *w_out, *w_q, *w_kv, *w_o, *w_up, *w_down;
    float* xres;
    bf16_t *W, *Wkv, *proj, *ybr, *merged, *xb, *kvm, *memb;
    float *rssq, *rmem, *xslot, *xs;
    unsigned* bar;
    int ph_lo, ph_hi;
};

typedef const __attribute__((address_space(4))) Params* KPtr;
typedef const __attribute__((address_space(4))) Params& KP;
DEVFN int opaque_tid() { int t = threadIdx.x; asm volatile("" : "+v"(t)); return t; }
DEVFN float bf2f(unsigned b) { return __uint_as_float(b << 16); }
typedef float f32x2 __attribute__((ext_vector_type(2)));
typedef __bf16 bf16x2v __attribute__((ext_vector_type(2)));
DEVFN unsigned pk2(float lo, float hi) { const f32x2 v = {lo, hi}; return __builtin_bit_cast(unsigned, __builtin_convertvector(v, bf16x2v)); }
DEVFN float wave_sum(float v) {
#pragma unroll
    for (int o = 32; o; o >>= 1) v += __shfl_xor(v, o);
    return v;
}
DEVFN float gelu_tanh(float x) { const float u = 1.5957691216f * (x + 0.044715f * x * x * x); return x * __builtin_amdgcn_rcpf(1.f + __expf(-u)); }
DEVFN float sigmoidf(float x) { return __builtin_amdgcn_rcpf(1.f + __expf(-x)); }
DEVFN void unpack4(u32x2 w, float (&o)[4]) { o[0] = bf2f(w.x & 0xffffu); o[1] = bf2f(w.x >> 16); o[2] = bf2f(w.y & 0xffffu); o[3] = bf2f(w.y >> 16); }
DEVFN void unpack8(u32x4 w, float (&o)[8]) {
    o[0] = bf2f(w.x & 0xffffu); o[1] = bf2f(w.x >> 16); o[2] = bf2f(w.y & 0xffffu); o[3] = bf2f(w.y >> 16);
    o[4] = bf2f(w.z & 0xffffu); o[5] = bf2f(w.z >> 16); o[6] = bf2f(w.w & 0xffffu); o[7] = bf2f(w.w >> 16);
}

namespace pg8 {
#define PG8_LAS __attribute__((address_space(3)))
constexpr int BM = 256, BK = 64, HALF = 128, HTB = HALF * BK * 2, STAGE_BYTES = 8 * HTB, NXCD = 8, WGM = 8;
__host__ __device__ __forceinline__ int lds_byte(int r, int c) { const int st = (r >> 4) * 2 + (c >> 5), rr = r & 15, cc = c & 31, ob = rr * 64 + cc * 2; return st * 1024 + (ob ^ (((ob >> 9) & 1) << 5)); }
__host__ __device__ __forceinline__ void stage_rc(int b, int& R, int& C) { const int st = b / 1024, sb = b % 1024, swz = sb ^ (((sb >> 9) & 1) << 5); R = (st >> 1) * 16 + swz / 64; C = (st & 1) * 32 + (swz % 64) / 2; }
__host__ __device__ __forceinline__ int perm32(int rho) { const int n = rho >> 4, i = rho & 15; return 8 * (i >> 2) + 4 * n + (i & 3); }
struct Unit { int pm, pn, sub; };
struct Gemm { const bf16_t* A; const bf16_t* Bt; int M, N, K, lda; unsigned asub, bsub; };
struct StaticOrder {
    int nM, nN, nwg, G, c, nsubs;
    __host__ __device__ void init(int M, int N, int G_, int c_, int nsubs_ = 1) { nM = M / BM; nN = N / BM; nwg = nM * nN; G = G_; c = c_; nsubs = nsubs_; }
    __host__ __device__ bool next(int i, Unit& u) const {
        const int ti = i / nsubs; u.sub = i - ti * nsubs;
        const long L = (long)ti * G + c; if (L >= nwg) return false;
        int wgid = (int)L; { const int q = nwg / NXCD, r = nwg % NXCD, xcd = wgid % NXCD, off = wgid / NXCD; wgid = (xcd < r ? xcd * (q + 1) : r * (q + 1) + (xcd - r) * q) + off; }
        const int nig = WGM * nN, gid = wgid / nig, fm = gid * WGM, gsz = (nM - fm) < WGM ? (nM - fm) : WGM;
        u.pm = fm + ((wgid % nig) % gsz); u.pn = (wgid % nig) / gsz; return true;
    }
    __device__ __forceinline__ void a_ready(const Unit&) const {}
    __device__ __forceinline__ void done(const Unit&) const {}
};
template <class Epi, class Sched, bool ALIGN_EPI = false, bool SP2 = false, bool I8 = false>
__device__ __forceinline__ void gemm_phase(PG8_LAS unsigned char* lds, const Gemm g, const Sched& S, const Epi& E) {
    const int tid = opaque_tid(), wid = __builtin_amdgcn_readfirstlane(tid >> 6), lane = tid & 63, wr = wid >> 2, wc = wid & 3, fr = lane & 15, fq = lane >> 4;
    const int K = g.K, nt = K / BK;
    unsigned voffA[2], voffB[2];
#pragma unroll
    for (int i = 0; i < 2; ++i) { int R, C; stage_rc(tid * 16 + i * 8192, R, C); const int Rb = Epi::PERM ? ((R & ~31) + perm32(R & 31)) : R;
        voffA[i] = (unsigned)(R * g.lda + C) * 2u; voffB[i] = (unsigned)(Rb * K + C) * 2u; }
    const size_t kstep = (size_t)(BK * 2);
    const size_t hstepA = (size_t)HALF * g.lda * 2, hstepB = (size_t)HALF * K * 2;
    const size_t tstepA = 2 * hstepA, tstepB = 2 * hstepB;
    const unsigned ldsw = (unsigned)wid * 1024u;
    const int aoff = lds_byte(wr * 64 + fr, fq * 8), boff = lds_byte(wc * 32 + fr, fq * 8);
#define PG8_SA(b, h) (((b) * 2 + (h)) * HTB)
#define PG8_SB(b, h) ((4 + (b) * 2 + (h)) * HTB)
#define PG8_STAGE(bufoff, gbase, voff) do { _Pragma("unroll") for (int _i = 0; _i < 2; ++_i) \
        __builtin_amdgcn_global_load_lds((const unsigned*)((const char*)(gbase) + (voff)[_i]), (PG8_LAS unsigned*)(lds + (bufoff) + ldsw + _i * 8192), 16, 0, 0); } while (0)
#define PG8_LDA(dst, b, h) do { _Pragma("unroll") for (int m = 0; m < 4; ++m) _Pragma("unroll") for (int k = 0; k < 2; ++k) dst[m][k] = *(const PG8_LAS bf16x8*)(lds + PG8_SA(b, h) + aoff + m * 2048 + k * 1024); } while (0)
#define PG8_LDB(dst, b, h) do { _Pragma("unroll") for (int n = 0; n < 2; ++n) _Pragma("unroll") for (int k = 0; k < 2; ++k) dst[n][k] = *(const PG8_LAS bf16x8*)(lds + PG8_SB(b, h) + boff + n * 2048 + k * 1024); } while (0)
#define PG8_MMA(ai, bj, At, Bt) do { __builtin_amdgcn_s_setprio(1); _Pragma("unroll") for (int m = 0; m < 4; ++m) _Pragma("unroll") for (int n = 0; n < 2; ++n) _Pragma("unroll") for (int k = 0; k < 2; ++k) { \
        if constexpr (I8) acc[ai][bj][m][n] = __builtin_bit_cast(f32x4, __builtin_amdgcn_mfma_i32_16x16x64_i8(__builtin_bit_cast(i32x4, Bt[n][k]), __builtin_bit_cast(i32x4, At[m][k]), __builtin_bit_cast(i32x4, acc[ai][bj][m][n]), 0, 0, 0)); \
        else acc[ai][bj][m][n] = __builtin_amdgcn_mfma_f32_16x16x32_bf16(Bt[n][k], At[m][k], acc[ai][bj][m][n], 0, 0, 0); } __builtin_amdgcn_s_setprio(0); } while (0)
#define PG8_WAIT_V(n) asm volatile("s_waitcnt vmcnt(" #n ")" ::: "memory")
#define PG8_WAIT_L(n) asm volatile("s_waitcnt lgkmcnt(" #n ")" ::: "memory")
#define PG8_BAR __builtin_amdgcn_s_barrier()
#define PG8_SCHED __builtin_amdgcn_sched_barrier(0)
    Unit cur, nxt; int ui = 0;
    if (!S.next(0, cur)) return;
    f32x4 acc[2][2][4][2];
#pragma unroll
    for (int a = 0; a < 2; ++a)
#pragma unroll
        for (int b = 0; b < 2; ++b)
#pragma unroll
            for (int m = 0; m < 4; ++m)
#pragma unroll
                for (int n = 0; n < 2; ++n) acc[a][b][m][n] = (f32x4){0.f, 0.f, 0.f, 0.f};
    bf16x8 At[4][2], B0[2][2], B1[2][2];
    const char* cA = (const char*)g.A + (size_t)cur.pm * tstepA + (size_t)cur.sub * g.asub; const char* cB = (const char*)g.Bt + (size_t)cur.pn * tstepB + (size_t)cur.sub * g.bsub;
    S.a_ready(cur);
    if constexpr (SP2) {
        PG8_STAGE(PG8_SB(0, 0), cB, voffB); PG8_STAGE(PG8_SB(0, 1), cB + hstepB, voffB); PG8_STAGE(PG8_SA(0, 0), cA, voffA); PG8_STAGE(PG8_SA(0, 1), cA + hstepA, voffA);
        if (wr == 1) PG8_BAR;
        PG8_WAIT_V(2); PG8_BAR;
        PG8_STAGE(PG8_SB(1, 0), cB + kstep, voffB); PG8_STAGE(PG8_SA(1, 0), cA + kstep, voffA); PG8_STAGE(PG8_SB(1, 1), cB + hstepB + kstep, voffB);
        PG8_WAIT_V(6); PG8_BAR;
    } else {
        PG8_STAGE(PG8_SB(0, 0), cB, voffB); PG8_STAGE(PG8_SA(0, 0), cA, voffA); PG8_STAGE(PG8_SB(0, 1), cB + hstepB, voffB); PG8_STAGE(PG8_SA(0, 1), cA + hstepA, voffA);
        if (wr == 1) PG8_BAR;
        PG8_WAIT_V(4); PG8_BAR;
        PG8_STAGE(PG8_SB(1, 0), cB + kstep, voffB); PG8_STAGE(PG8_SA(1, 0), cA + kstep, voffA); PG8_STAGE(PG8_SB(1, 1), cB + hstepB + kstep, voffB);
        PG8_WAIT_V(6); PG8_BAR;
    }
    for (;;) {
        const bool has_next = S.next(ui + 1, nxt);
        const char* nA = has_next ? (const char*)g.A + (size_t)nxt.pm * tstepA + (size_t)nxt.sub * g.asub : cA; const char* nB = has_next ? (const char*)g.Bt + (size_t)nxt.pn * tstepB + (size_t)nxt.sub * g.bsub : cB;
        for (int t = 0; t < nt; t += 2) {
            const bool last = (t == nt - 2);
            const char* a1 = cA + (size_t)(t + 1) * kstep;
            const char* a2 = last ? nA : cA + (size_t)(t + 2) * kstep; const char* b2 = last ? nB : cB + (size_t)(t + 2) * kstep;
            const char* a3 = a2 + kstep; const char* b3 = b2 + kstep;
            if (last && has_next) S.a_ready(nxt);
            if constexpr (SP2) {
            PG8_LDB(B0, 0, 0); PG8_LDB(B1, 0, 1); PG8_SCHED; PG8_LDA(At, 0, 0); PG8_STAGE(PG8_SA(1, 1), a1 + hstepA, voffA);
            PG8_WAIT_V(8); PG8_WAIT_L(0); PG8_BAR; PG8_MMA(0, 0, At, B0); PG8_MMA(0, 1, At, B1); PG8_BAR; PG8_SCHED;
            PG8_LDA(At, 0, 1); PG8_STAGE(PG8_SB(0, 0), b2, voffB); PG8_STAGE(PG8_SB(0, 1), b2 + hstepB, voffB); PG8_STAGE(PG8_SA(0, 0), a2, voffA);
            PG8_WAIT_V(8); PG8_WAIT_L(0); PG8_BAR; PG8_MMA(1, 0, At, B0); PG8_MMA(1, 1, At, B1); PG8_BAR; PG8_SCHED;
            PG8_LDB(B0, 1, 0); PG8_LDB(B1, 1, 1); PG8_SCHED; PG8_LDA(At, 1, 0); PG8_STAGE(PG8_SA(0, 1), a2 + hstepA, voffA);
            PG8_WAIT_V(8); PG8_WAIT_L(0); PG8_BAR; PG8_MMA(0, 0, At, B0); PG8_MMA(0, 1, At, B1); PG8_BAR; PG8_SCHED;
            PG8_LDA(At, 1, 1); PG8_STAGE(PG8_SB(1, 0), b3, voffB); PG8_STAGE(PG8_SB(1, 1), b3 + hstepB, voffB); PG8_STAGE(PG8_SA(1, 0), a3, voffA);
            PG8_WAIT_V(8); PG8_WAIT_L(0); PG8_BAR; PG8_MMA(1, 0, At, B0); PG8_MMA(1, 1, At, B1); PG8_BAR; PG8_SCHED;
            } else {
            PG8_LDB(B0, 0, 0); PG8_SCHED; PG8_LDA(At, 0, 0); PG8_STAGE(PG8_SA(1, 1), a1 + hstepA, voffA);
            PG8_WAIT_L(8); PG8_BAR; PG8_WAIT_L(0); PG8_MMA(0, 0, At, B0); PG8_BAR; PG8_SCHED;
            PG8_LDB(B1, 0, 1); PG8_STAGE(PG8_SB(0, 0), b2, voffB);
            PG8_BAR; PG8_WAIT_L(0); PG8_MMA(0, 1, At, B1); PG8_BAR;
            PG8_LDA(At, 0, 1); PG8_STAGE(PG8_SA(0, 0), a2, voffA);
            PG8_BAR; PG8_WAIT_L(0); PG8_MMA(1, 0, At, B0); PG8_BAR; PG8_SCHED;
            PG8_STAGE(PG8_SB(0, 1), b2 + hstepB, voffB);
            PG8_WAIT_V(6); PG8_BAR; PG8_MMA(1, 1, At, B1); PG8_BAR;
            PG8_LDB(B0, 1, 0); PG8_SCHED; PG8_LDA(At, 1, 0); PG8_STAGE(PG8_SA(0, 1), a2 + hstepA, voffA);
            PG8_WAIT_L(8); PG8_BAR; PG8_WAIT_L(0); PG8_MMA(0, 0, At, B0); PG8_BAR; PG8_SCHED;
            PG8_LDB(B1, 1, 1); PG8_STAGE(PG8_SB(1, 0), b3, voffB);
            PG8_BAR; PG8_WAIT_L(0); PG8_MMA(0, 1, At, B1); PG8_BAR;
            PG8_LDA(At, 1, 1); PG8_STAGE(PG8_SA(1, 0), a3, voffA);
            PG8_BAR; PG8_WAIT_L(0); PG8_MMA(1, 0, At, B0); PG8_BAR; PG8_SCHED;
            PG8_STAGE(PG8_SB(1, 1), b3 + hstepB, voffB);
            PG8_WAIT_V(6); PG8_BAR; PG8_MMA(1, 1, At, B1); PG8_BAR;
            }
        }
        if constexpr (ALIGN_EPI) { if (wr == 0) PG8_BAR; }
        if (!E.after_drain) { E(acc, cur, wr, wc, fr, fq); S.done(cur); }
        if (!has_next) break;
#pragma unroll
        for (int a = 0; a < 2; ++a)
#pragma unroll
            for (int b = 0; b < 2; ++b)
#pragma unroll
                for (int m = 0; m < 4; ++m)
#pragma unroll
                    for (int n = 0; n < 2; ++n) acc[a][b][m][n] = (f32x4){0.f, 0.f, 0.f, 0.f};
        cur = nxt; cA = nA; cB = nB; ++ui;
        if constexpr (ALIGN_EPI) { if (wr == 1) PG8_BAR; }
    }
    PG8_WAIT_V(0);
    if constexpr (!ALIGN_EPI) { if (wr == 0) PG8_BAR; }
    PG8_BAR;
    if (E.after_drain) { E.fused(acc, cur, wr, wc, fr, fq, lds, wid, lane); S.done(cur); }
#undef PG8_SA
#undef PG8_SB
#undef PG8_STAGE
#undef PG8_LDA
#undef PG8_LDB
#undef PG8_MMA
#undef PG8_WAIT_V
#undef PG8_WAIT_L
#undef PG8_BAR
#undef PG8_SCHED
}
}

struct EpiRT {
    static constexpr bool PERM = true;
    int mode; bf16_t* out; int ldc; const float* rowscale; int rs_mode  ; int act; float* ssq; const bf16_t* gate; bool first;
    bool after_drain; int gidx; unsigned want; KPtr pp;
    int i8; const float* xs; const unsigned* wcol; int rpar;
    __device__ __forceinline__ void operator()(const f32x4 (&acc)[2][2][4][2], const pg8::Unit& u, int wr, int wc, int fr, int fq) const {
        const int bcol = u.pn * 256;
        const int row0 = u.pm * 256 + wr * 64 + fr, col0 = bcol + wc * 32 + 8 * fq;
        if (mode == 0) {
            int a = act; float* sq = ssq;
            if (act < 0) { a = (bcol >= COL_GATE) ? 2 : ((bcol >= COL_SU && bcol < COL_PC) ? 1 : 0); sq = (bcol >= COL_SV && bcol < COL_PC) ? ssq : nullptr; }
            float rsv[2][4]; u32x4 wc0[2], wc1[2];
            {
                f32x4 q[2][4]; float xv[2][4];
                if (rs_mode == 2) {
#pragma unroll
                    for (int ai = 0; ai < 2; ++ai)
#pragma unroll
                        for (int m = 0; m < 4; ++m) q[ai][m] = *(const f32x4*)(rowscale + 4 * (size_t)(row0 + ai * 128 + m * 16));
                } else if (rs_mode == 1) {
#pragma unroll
                    for (int ai = 0; ai < 2; ++ai)
#pragma unroll
                        for (int m = 0; m < 4; ++m) q[ai][m] = (f32x4){rowscale[row0 + ai * 128 + m * 16], 0.f, 0.f, 0.f};
                }
                if (i8) {
#pragma unroll
                    for (int ai = 0; ai < 2; ++ai)
#pragma unroll
                        for (int m = 0; m < 4; ++m) xv[ai][m] = xs[row0 + ai * 128 + m * 16];
#pragma unroll
                    for (int bj = 0; bj < 2; ++bj) { wc0[bj] = *(const u32x4*)(wcol + col0 + bj * 128); wc1[bj] = *(const u32x4*)(wcol + col0 + bj * 128 + 4); }
                }
#pragma unroll
                for (int ai = 0; ai < 2; ++ai)
#pragma unroll
                    for (int m = 0; m < 4; ++m) {
                        float rs = 1.f;
                        if (rs_mode == 1) rs = q[ai][m][0];
                        else if (rs_mode == 2) rs = rsqrtf(((q[ai][m][0] + q[ai][m][1]) + (q[ai][m][2] + q[ai][m][3])) * (1.f / D) + EPS);
                        if (i8) rs *= xv[ai][m] * (1.f / 127.f);
                        rsv[ai][m] = rs;
                    }
            }
#pragma unroll
            for (int ai = 0; ai < 2; ++ai)
#pragma unroll
                for (int m = 0; m < 4; ++m) {
                    const int row = row0 + ai * 128 + m * 16;
                    const float rs = rsv[ai][m];
                    float ss = 0.f;
                    bf16_t* orow = out + (size_t)row * ldc + col0;
#pragma unroll
                    for (int bj = 0; bj < 2; ++bj) {
                        float v[8];
#pragma unroll
                        for (int j = 0; j < 4; ++j) {
                            const float a0 = i8 ? (float)__float_as_int(acc[ai][bj][m][0][j]) : acc[ai][bj][m][0][j], a1 = i8 ? (float)__float_as_int(acc[ai][bj][m][1][j]) : acc[ai][bj][m][1][j];
                            v[j] = a0 * rs; v[4 + j] = a1 * rs; }
                        if (i8) {
                            const u32x4 c0 = wc0[bj], c1 = wc1[bj];
                            v[0] *= __uint_as_float(c0.x); v[1] *= __uint_as_float(c0.y); v[2] *= __uint_as_float(c0.z); v[3] *= __uint_as_float(c0.w);
                            v[4] *= __uint_as_float(c1.x); v[5] *= __uint_as_float(c1.y); v[6] *= __uint_as_float(c1.z); v[7] *= __uint_as_float(c1.w);
                        }
                        if (a == 1) {
#pragma unroll
                            for (int j = 0; j < 8; ++j) v[j] = gelu_tanh(v[j]);
                        } else if (a == 2) {
#pragma unroll
                            for (int j = 0; j < 8; ++j) v[j] = sigmoidf(v[j]);
                        } else if (a == 3) {
#pragma unroll
                            for (int j = 0; j < 8; ++j) { const float t = fmaxf(v[j], 0.f); v[j] = t * t; }
                        }
                        u32x4 w; w.x = pk2(v[0], v[1]); w.y = pk2(v[2], v[3]); w.z = pk2(v[4], v[5]); w.w = pk2(v[6], v[7]);
                        *(u32x4*)(orow + bj * 128) = w;
                    }
                }
        } else {
#pragma unroll
            for (int ai = 0; ai < 2; ++ai)
#pragma unroll
              for (int mh = 0; mh < 2; ++mh) {
                u32x4 gv[2][2], pq[2][2];
#pragma unroll
                for (int mm = 0; mm < 2; ++mm)
#pragma unroll
                    for (int bj = 0; bj < 2; ++bj) gv[mm][bj] = *(const u32x4*)(gate + (size_t)(row0 + ai * 128 + (mh * 2 + mm) * 16) * IN_DIM + u.sub * D + col0 + bj * 128);
                if (u.sub != 0) {
#pragma unroll
                    for (int mm = 0; mm < 2; ++mm)
#pragma unroll
                        for (int bj = 0; bj < 2; ++bj) pq[mm][bj] = *(const u32x4*)(out + (size_t)(row0 + ai * 128 + (mh * 2 + mm) * 16) * D + col0 + bj * 128);
                }
#pragma unroll
                for (int mm = 0; mm < 2; ++mm) {
                    const int m = mh * 2 + mm;
                    const int row = row0 + ai * 128 + m * 16;
#pragma unroll
                    for (int bj = 0; bj < 2; ++bj) {
                        const int col = col0 + bj * 128;
                        float g[8]; unpack8(gv[mm][bj], g);
                        float v[8];
#pragma unroll
                        for (int j = 0; j < 4; ++j) { v[j] = acc[ai][bj][m][0][j] * g[j]; v[4 + j] = acc[ai][bj][m][1][j] * g[4 + j]; }
                        bf16_t* mp = out + (size_t)row * D + col;
                        if (u.sub != 0) { float pv[8]; unpack8(pq[mm][bj], pv);
#pragma unroll
                            for (int j = 0; j < 8; ++j) v[j] += pv[j]; }
                        u32x4 w; w.x = pk2(v[0], v[1]); w.y = pk2(v[2], v[3]); w.z = pk2(v[4], v[5]); w.w = pk2(v[6], v[7]);
                        *(u32x4*)mp = w;
                    }
                }
              }
        }
    }

    __device__ __forceinline__ void fused(f32x4 (&acc)[2][2][4][2], const pg8::Unit& u, int wr, int wc, int fr, int fq, PG8_LAS unsigned char* lds, int wid, int lane) const {
        PG8_LAS float* P = (PG8_LAS float*)lds;
        PG8_LAS float* Sr = (PG8_LAS float*)(lds + 4096);
        const int tid = wid * 64 + lane;
        KPtr q_ = pp; asm volatile("" : "+s"(q_));
        float* const x = q_->xres; bf16_t* const xb = q_->xb; float* const rssq = q_->rssq + (size_t)rpar * T * 4; const float* const rssq_old = q_->rssq + (size_t)(rpar ^ 1) * T * 4; float* const xslot = q_->xslot;
        signed char* const xq = (gidx % 6) == 3 ? (signed char*)q_->ybr : (signed char*)q_->merged; float* const xsp = q_->xs;
        unsigned* const pcnt = q_->bar + 64 * 64; const float* const gvec = q_->g_norm + gidx * D;
        const bool last = gidx == (DEPTH - 1) * 6 + 5;
        const bool quant = ((gidx % 6) == 5 && !last) || (gidx % 6) == 3;
        PG8_LAS float* Sq = (PG8_LAS float*)(lds + 4096 + 1024);
        const int col0 = u.pn * 256 + wc * 32 + 8 * fq;
        u32x4 xv[2][4][2]; f32x4 gq[2][2];
#pragma unroll
        for (int ai = 0; ai < 2; ++ai)
#pragma unroll
            for (int m = 0; m < 4; ++m) {
                float s = 0.f;
#pragma unroll
                for (int bj = 0; bj < 2; ++bj)
#pragma unroll
                    for (int n = 0; n < 2; ++n) { const f32x4 v = acc[ai][bj][m][n]; s += (v[0] * v[0] + v[1] * v[1]) + (v[2] * v[2] + v[3] * v[3]); }
                s += __shfl_xor(s, 16); s += __shfl_xor(s, 32);
                if (fq == 0) P[(ai * 128 + wr * 64 + m * 16 + fr) * 4 + wc] = s;
            }
        asm volatile("s_waitcnt lgkmcnt(0)" ::: "memory"); __builtin_amdgcn_s_barrier(); asm volatile("" ::: "memory");
        unsigned* slots = (unsigned*)xslot + (size_t)(u.pm * 256) * 4;
        if (tid < 256) {
            const float t = (P[tid * 4 + 0] + P[tid * 4 + 1]) + (P[tid * 4 + 2] + P[tid * 4 + 3]);
            __hip_atomic_store(slots + tid * 4 + u.pn, __float_as_uint(t), __ATOMIC_RELAXED, __HIP_MEMORY_SCOPE_AGENT);
        }
        asm volatile("s_waitcnt vmcnt(0)" ::: "memory");
        if (tid < 256 && lane == 0) __hip_atomic_fetch_add(pcnt + 64 * u.pm, 1u, __ATOMIC_RELAXED, __HIP_MEMORY_SCOPE_AGENT);
#pragma unroll
        for (int ai = 0; ai < 2; ++ai)
#pragma unroll
            for (int m = 0; m < 4; ++m)
#pragma unroll
                for (int bj = 0; bj < 2; ++bj) xv[ai][m][bj] = *(const u32x4*)(xb + (size_t)(u.pm * 256 + ai * 128 + wr * 64 + m * 16 + fr) * D + col0 + bj * 128);
#pragma unroll
        for (int bj = 0; bj < 2; ++bj) { gq[bj][0] = *(const f32x4*)(gvec + col0 + bj * 128); gq[bj][1] = *(const f32x4*)(gvec + col0 + bj * 128 + 4); }
        if (wid == 0) {
            while ((unsigned)__builtin_amdgcn_readfirstlane(__hip_atomic_load(pcnt + 64 * u.pm, __ATOMIC_RELAXED, __HIP_MEMORY_SCOPE_AGENT)) < want) __builtin_amdgcn_s_sleep(1);
        }
        asm volatile("s_waitcnt vmcnt(0) lgkmcnt(0)" ::: "memory"); __builtin_amdgcn_s_barrier(); asm volatile("" ::: "memory");
        if (tid < 256) {
            float t = 0.f;
#pragma unroll
            for (int q = 0; q < 4; ++q) t += __uint_as_float(__hip_atomic_load(slots + tid * 4 + q, __ATOMIC_RELAXED, __HIP_MEMORY_SCOPE_AGENT));
            Sr[tid] = rsqrtf(t * (1.f / D) + EPS);
            if (quant) {
                const f32x4 q4 = *(const f32x4*)(rssq_old + (size_t)(u.pm * 256 + tid) * 4);
                const float step = 5.5f * sqrtf(((q4[0] + q4[1]) + (q4[2] + q4[3])) * (1.f / D) + 1.0f) * (1.f / 127.f);
                Sq[tid] = __builtin_amdgcn_rcpf(step);
                if (u.pn == 0) xsp[u.pm * 256 + tid] = step;
            }
        }
        asm volatile("s_waitcnt lgkmcnt(0)" ::: "memory"); __builtin_amdgcn_s_barrier(); asm volatile("" ::: "memory");
#pragma unroll
        for (int ai = 0; ai < 2; ++ai)
#pragma unroll
            for (int m = 0; m < 4; ++m) {
                const int r = ai * 128 + wr * 64 + m * 16 + fr;
                const float ry = Sr[r];
                const size_t off = (size_t)(u.pm * 256 + r) * D + col0;
                float s2 = 0.f;
#pragma unroll
                for (int bj = 0; bj < 2; ++bj) {
                    float xo[8]; unpack8(xv[ai][m][bj], xo);
                    const f32x4 g0 = gq[bj][0], g1 = gq[bj][1];
                    const f32x4 v0 = (f32x4){xo[0], xo[1], xo[2], xo[3]} + acc[ai][bj][m][0] * ry * g0, v1 = (f32x4){xo[4], xo[5], xo[6], xo[7]} + acc[ai][bj][m][1] * ry * g1;
                    u32x4 w; w.x = pk2(v0[0], v0[1]); w.y = pk2(v0[2], v0[3]); w.z = pk2(v1[0], v1[1]); w.w = pk2(v1[2], v1[3]);
                    float vr[8]; unpack8(w, vr);
                    s2 += (vr[0] * vr[0] + vr[1] * vr[1]) + (vr[2] * vr[2] + vr[3] * vr[3]) + (vr[4] * vr[4] + vr[5] * vr[5]) + (vr[6] * vr[6] + vr[7] * vr[7]);
                    *(u32x4*)(xb + off + bj * 128) = w;
                    if (last) { *(f32x4*)(x + off + bj * 128) = v0; *(f32x4*)(x + off + bj * 128 + 4) = v1; }
                    if (quant) {
                        const float is = Sq[r]; unsigned b[8];
#pragma unroll
                        for (int j = 0; j < 8; ++j) { int qv = __float2int_rn(vr[j] * is); qv = qv > 127 ? 127 : (qv < -127 ? -127 : qv); b[j] = (unsigned)qv & 255u; }
                        u32x2 qw; qw.x = b[0] | (b[1] << 8) | (b[2] << 16) | (b[3] << 24); qw.y = b[4] | (b[5] << 8) | (b[6] << 16) | (b[7] << 24);
                        *(u32x2*)(xq + off + bj * 128) = qw;
                    }
                }
                s2 += __shfl_xor(s2, 16); s2 += __shfl_xor(s2, 32);
                if (fq == 0) P[r * 4 + wc] = s2;
            }
        asm volatile("s_waitcnt lgkmcnt(0)" ::: "memory"); __builtin_amdgcn_s_barrier(); asm volatile("" ::: "memory");
        if (tid < 256) rssq[(size_t)(u.pm * 256 + tid) * 4 + u.pn] = (P[tid * 4 + 0] + P[tid * 4 + 1]) + (P[tid * 4 + 2] + P[tid * 4 + 3]);
        asm volatile("s_waitcnt lgkmcnt(0)" ::: "memory"); __builtin_amdgcn_s_barrier(); asm volatile("" ::: "memory");
    }
};

DEVFN void prep_rows(const float* __restrict__ src, float* dst, bf16_t* dstb, float* r, bool partials, int nrows) {
    const int tid = opaque_tid(), lane = tid & 63, gw = blockIdx.x * 8 + (tid >> 6), nw = gridDim.x * 8;
    for (int row = gw; row < nrows; row += nw) {
        float ss = 0.f;
#pragma unroll
        for (int i = 0; i < 4; ++i) {
            const size_t o = (size_t)row * D + i * 256 + lane * 4;
            const f32x4 v = *(const f32x4*)(src + o);
            ss += (v[0] * v[0] + v[1] * v[1]) + (v[2] * v[2] + v[3] * v[3]);
            if (dst) *(f32x4*)(dst + o) = v;
            u32x2 w; w.x = pk2(v[0], v[1]); w.y = pk2(v[2], v[3]);
            *(u32x2*)(dstb + o) = w;
        }
        ss = wave_sum(ss);
        if (lane == 0) { if (partials) *(f32x4*)(r + 4 * (size_t)row) = (f32x4){ss, 0.f, 0.f, 0.f}; else r[row] = rsqrtf(ss * (1.f / D) + EPS); }
    }
}
DEVFN void convert_mat(const float* __restrict__ src, int src_ld, int K, int N, bf16_t* dst, const float* gvec, int qcols, float qscale, float* tile, int vb, int nb) {
    const int tn = N / 64, ntiles = (K / 64) * tn, tid = opaque_tid();
    const int r0 = tid >> 4, c4 = (tid & 15) * 4;
    f32x4 va, vb4; float sa = 1.f, sb = 1.f;
    int t = vb;
    if (t < ntiles) {
        const int k0 = (t / tn) * 64, n0 = (t % tn) * 64;
        va = *(const f32x4*)(src + (size_t)(k0 + r0) * src_ld + n0 + c4); vb4 = *(const f32x4*)(src + (size_t)(k0 + r0 + 32) * src_ld + n0 + c4);
        if (gvec) { sa = gvec[k0 + r0]; sb = gvec[k0 + r0 + 32]; }
    }
    while (t < ntiles) {
        const int k0 = (t / tn) * 64, n0 = (t % tn) * 64;
        tile[r0 * 65 + c4 + 0] = va[0] * sa; tile[r0 * 65 + c4 + 1] = va[1] * sa; tile[r0 * 65 + c4 + 2] = va[2] * sa; tile[r0 * 65 + c4 + 3] = va[3] * sa;
        tile[(r0 + 32) * 65 + c4 + 0] = vb4[0] * sb; tile[(r0 + 32) * 65 + c4 + 1] = vb4[1] * sb; tile[(r0 + 32) * 65 + c4 + 2] = vb4[2] * sb; tile[(r0 + 32) * 65 + c4 + 3] = vb4[3] * sb;
        const int tnx = t + nb;
        if (tnx < ntiles) {
            const int k1 = (tnx / tn) * 64, n1 = (tnx % tn) * 64;
            va = *(const f32x4*)(src + (size_t)(k1 + r0) * src_ld + n1 + c4); vb4 = *(const f32x4*)(src + (size_t)(k1 + r0 + 32) * src_ld + n1 + c4);
            if (gvec) { sa = gvec[k1 + r0]; sb = gvec[k1 + r0 + 32]; }
        }
        __syncthreads();
        {
            const int n = tid >> 3, kg = tid & 7;
            const float sc = (n0 + n < qcols) ? qscale : 1.f;
            float v[8];
#pragma unroll
            for (int i = 0; i < 8; ++i) v[i] = tile[(kg * 8 + i) * 65 + n] * sc;
            u32x4 w; w.x = pk2(v[0], v[1]); w.y = pk2(v[2], v[3]); w.z = pk2(v[4], v[5]); w.w = pk2(v[6], v[7]);
            *(u32x4*)(dst + (size_t)(n0 + n) * K + k0 + kg * 8) = w;
        }
        __syncthreads();
        t = tnx;
    }
}
DEVFN void convert_w_i8(const float* __restrict__ src, int N, const float* gvec, int qcols, const unsigned* wcol, signed char* dst, float* tile, int vb, int nb) {
    const int tn = N / 64, ntiles = (D / 64) * tn, tid = opaque_tid();
    const int r0 = tid >> 4, c4 = (tid & 15) * 4;
    f32x4 va, vb4; float sa = 1.f, sb = 1.f;
    int t = vb;
    if (t < ntiles) {
        const int k0 = (t / tn) * 64, n0 = (t % tn) * 64;
        va = *(const f32x4*)(src + (size_t)(k0 + r0) * N + n0 + c4); vb4 = *(const f32x4*)(src + (size_t)(k0 + r0 + 32) * N + n0 + c4);
        sa = gvec[k0 + r0]; sb = gvec[k0 + r0 + 32];
    }
    while (t < ntiles) {
        const int k0 = (t / tn) * 64, n0 = (t % tn) * 64;
        tile[r0 * 65 + c4 + 0] = va[0] * sa; tile[r0 * 65 + c4 + 1] = va[1] * sa; tile[r0 * 65 + c4 + 2] = va[2] * sa; tile[r0 * 65 + c4 + 3] = va[3] * sa;
        tile[(r0 + 32) * 65 + c4 + 0] = vb4[0] * sb; tile[(r0 + 32) * 65 + c4 + 1] = vb4[1] * sb; tile[(r0 + 32) * 65 + c4 + 2] = vb4[2] * sb; tile[(r0 + 32) * 65 + c4 + 3] = vb4[3] * sb;
        const int tnx = t + nb;
        if (tnx < ntiles) {
            const int k1 = (tnx / tn) * 64, n1 = (tnx % tn) * 64;
            va = *(const f32x4*)(src + (size_t)(k1 + r0) * N + n1 + c4); vb4 = *(const f32x4*)(src + (size_t)(k1 + r0 + 32) * N + n1 + c4);
            sa = gvec[k1 + r0]; sb = gvec[k1 + r0 + 32];
        }
        __syncthreads();
        {
            const int n = tid >> 3, kg = tid & 7;
            const float sc = ((n0 + n < qcols) ? 0.125f : 1.f) * 127.f * __builtin_amdgcn_rcpf(fmaxf(__uint_as_float(wcol[n0 + n]), 1e-30f));
            unsigned b[8];
#pragma unroll
            for (int i = 0; i < 8; ++i) { int qv = __float2int_rn(tile[(kg * 8 + i) * 65 + n] * sc); qv = qv > 127 ? 127 : (qv < -127 ? -127 : qv); b[i] = (unsigned)qv & 255u; }
            u32x2 w; w.x = b[0] | (b[1] << 8) | (b[2] << 16) | (b[3] << 24); w.y = b[4] | (b[5] << 8) | (b[6] << 16) | (b[7] << 24);
            *(u32x2*)(dst + (size_t)(n0 + n) * D + k0 + kg * 8) = w;
        }
        __syncthreads();
        t = tnx;
    }
}
DEVFN void wabs_pass(const float* __restrict__ src, int N, const float* gvec, int qcols, unsigned* wcol, int vb, int nb) {
    const int tid = opaque_tid();
    const int idx = vb * 512 + tid, cg4 = idx % (N / 4), ks = idx / (N / 4);
    const int rows = (D * (N / 4) + nb * 512 - 1) / (nb * 512) + 1;
    const int k0 = ks * rows, k1 = (k0 + rows) < D ? (k0 + rows) : D;
    if (k0 < D) {
        f32x4 m = (f32x4){0.f, 0.f, 0.f, 0.f};
        for (int kb = k0; kb < k1; kb += 4) {
            f32x4 v[4]; float s[4];
#pragma unroll
            for (int j = 0; j < 4; ++j) { const int k = (kb + j) < k1 ? (kb + j) : (k1 - 1); v[j] = *(const f32x4*)(src + (size_t)k * N + cg4 * 4); s[j] = fabsf(gvec[k]); }
#pragma unroll
            for (int j = 0; j < 4; ++j) { m[0] = fmaxf(m[0], fabsf(v[j][0]) * s[j]); m[1] = fmaxf(m[1], fabsf(v[j][1]) * s[j]); m[2] = fmaxf(m[2], fabsf(v[j][2]) * s[j]); m[3] = fmaxf(m[3], fabsf(v[j][3]) * s[j]); }
        }
        const float f = (cg4 * 4 < qcols) ? 0.125f : 1.f;
#pragma unroll
        for (int j = 0; j < 4; ++j) atomicMax(wcol + cg4 * 4 + j, __float_as_uint(m[j] * f));
    }
}

DEVFN void convert_set(KP p, int l, int mask, float* tile, int vb, int nb) {
    if (mask & 1) { if (l == 0) convert_mat(p.w_in + (size_t)l * D * IN_DIM, IN_DIM, D, IN_DIM, p.W + W_IN, p.g_norm + (l * 6 + 0) * D, 512, 0.125f, tile, vb, nb); else convert_w_i8(p.w_in + (size_t)l * D * IN_DIM, IN_DIM, p.g_norm + (l * 6 + 0) * D, 512, p.bar + WCOL_IN + (size_t)l * IN_DIM, (signed char*)(p.W + W_IN), tile, vb, nb); }
    if (mask & 2) {
        for (int g = 0; g < 4; ++g) convert_mat(p.w_pool + ((size_t)l * 4 + g) * 128 * 128, 128, 128, 128, p.W + W_POOL + (size_t)g * 128 * 128, nullptr, 0, 1.f, tile, vb, nb);
        for (int n = 0; n < 3; ++n) convert_mat(p.w_branch + ((size_t)l * 3 + n) * 512 * D, D, 512, D, p.W + W_BR + (size_t)n * D * 512, nullptr, 0, 1.f, tile, vb, nb);
        convert_mat(p.w_out + (size_t)l * D * D, D, D, D, p.W + W_OUT, nullptr, 0, 1.f, tile, vb, nb);
    }
    if (mask & 4) convert_mat(p.w_q + (size_t)l * D * 512, 512, D, 512, p.W + W_Q, p.g_norm + (l * 6 + 2) * D, 512, 0.08838834764831845f, tile, vb, nb);
    if (mask & 8) {
        convert_mat(p.w_o + (size_t)l * 512 * D, D, 512, D, p.W + W_O, nullptr, 0, 1.f, tile, vb, nb);
        convert_w_i8(p.w_up + (size_t)l * D * DFF, DFF, p.g_norm + (l * 6 + 4) * D, 0, p.bar + WCOL_UP + (size_t)l * DFF, (signed char*)(p.W + W_UP), tile, vb, nb);
        convert_mat(p.w_down + (size_t)l * DFF * D, D, DFF, D, p.W + W_DN, nullptr, 0, 1.f, tile, vb, nb);
    }
}

DEVFN void attn_item(KP p, int l, int item, bf16_t* vt  ) {
    const int tid = opaque_tid(), lane = tid & 63, w = tid >> 6, fr = lane & 15, fq = lane >> 4;
    const int b = item >> 7, c = (item >> 1) & 63, kvh = item & 1;
    const int t0 = b * SEQ + c * 64;
    const bf16_t* proj = p.proj;
    const int g = w >> 1, qh = w & 1, hq = kvh * 4 + g;
    const float sink = p.sinks[l * 8 + hq];
    bf16x8 Qf[2][2];
#pragma unroll
    for (int qt = 0; qt < 2; ++qt)
#pragma unroll
        for (int db = 0; db < 2; ++db)
            Qf[qt][db] = *(const bf16x8*)(proj + (size_t)(t0 + qh * 32 + qt * 16 + fr) * IN_DIM + hq * 64 + db * 32 + fq * 8);
    for (int idx = tid; idx < 192 * 8; idx += 512) {
        const int key = idx >> 3, dg = idx & 7;
        const bool valid = (c * 64 - 128 + key) >= 0;
        u32x4 raw = (u32x4){0u, 0u, 0u, 0u};
        if (valid) raw = *(const u32x4*)(proj + (size_t)(t0 - 128 + key) * IN_DIM + COL_V + kvh * 64 + dg * 8);
        const unsigned ws[4] = {raw.x, raw.y, raw.z, raw.w};
#pragma unroll
        for (int i = 0; i < 4; ++i) { vt[(dg * 8 + 2 * i) * 200 + (key ^ (dg << 2))] = (bf16_t)(ws[i] & 0xffffu); vt[(dg * 8 + 2 * i + 1) * 200 + (key ^ (dg << 2))] = (bf16_t)(ws[i] >> 16); }
    }
    bf16_t* kl = vt + 64 * 200;
    for (int idx = tid; idx < 192 * 8; idx += 512) {
        const int key = idx >> 3, dg = idx & 7;
        u32x4 raw = (u32x4){0u, 0u, 0u, 0u};
        if ((c * 64 - 128 + key) >= 0) raw = *(const u32x4*)(proj + (size_t)(t0 - 128 + key) * IN_DIM + COL_K + kvh * 64 + dg * 8);
        *(u32x4*)(kl + key * 72 + dg * 8) = raw;
    }
    __syncthreads();
    f32x4 s[12][2];
    const int kt_start = c >= 2 ? 0 : (2 - c) * 4;
#pragma unroll
    for (int kt = 0; kt < 12; ++kt) {
        if (kt >= kt_start) {
            const bf16_t* kp = kl + (kt * 16 + fr) * 72 + fq * 8;
            const bf16x8 k0 = *(const bf16x8*)kp, k1 = *(const bf16x8*)(kp + 32);
#pragma unroll
            for (int qt = 0; qt < 2; ++qt) {
                f32x4 a = (f32x4){0.f, 0.f, 0.f, 0.f};
                a = __builtin_amdgcn_mfma_f32_16x16x32_bf16(k0, Qf[qt][0], a, 0, 0, 0);
                a = __builtin_amdgcn_mfma_f32_16x16x32_bf16(k1, Qf[qt][1], a, 0, 0, 0);
                s[kt][qt] = a;
            }
        } else {
            s[kt][0] = (f32x4){-1e30f, -1e30f, -1e30f, -1e30f}; s[kt][1] = s[kt][0];
        }
    }
    bf16x8 Pf[2][6];
#pragma unroll
    for (int qt = 0; qt < 2; ++qt) {
        float m = sink;
#pragma unroll
        for (int kt = 0; kt < 12; ++kt) m = fmaxf(m, fmaxf(fmaxf(s[kt][qt][0], s[kt][qt][1]), fmaxf(s[kt][qt][2], s[kt][qt][3])));
        m = fmaxf(m, __shfl_xor(m, 16)); m = fmaxf(m, __shfl_xor(m, 32));
        float sum = 0.f;
#pragma unroll
        for (int kt = 0; kt < 12; ++kt) {
#pragma unroll
            for (int j = 0; j < 4; ++j) { const float e = __expf(s[kt][qt][j] - m); s[kt][qt][j] = e; sum += e; }
        }
        sum += __shfl_xor(sum, 16); sum += __shfl_xor(sum, 32);
        sum += __expf(sink - m);
        const float inv = __builtin_amdgcn_rcpf(sum);
#pragma unroll
        for (int i = 0; i < 6; ++i) {
            u32x4 w4;
            w4.x = pk2(s[2 * i][qt][0] * inv, s[2 * i][qt][1] * inv); w4.y = pk2(s[2 * i][qt][2] * inv, s[2 * i][qt][3] * inv);
            w4.z = pk2(s[2 * i + 1][qt][0] * inv, s[2 * i + 1][qt][1] * inv); w4.w = pk2(s[2 * i + 1][qt][2] * inv, s[2 * i + 1][qt][3] * inv);
            Pf[qt][i] = __builtin_bit_cast(bf16x8, w4);
        }
    }
#pragma unroll
    for (int dt = 0; dt < 4; ++dt) {
        f32x4 o0 = (f32x4){0.f, 0.f, 0.f, 0.f}, o1 = o0;
#pragma unroll
        for (int i = 0; i < 6; ++i) {
            const bf16_t* vp = vt + (dt * 16 + fr) * 200 + ((32 * i + fq * 4) ^ ((dt * 2 + (fr >> 3)) << 2));
            u32x4 vv; const u32x2 lo = *(const u32x2*)vp, hi = *(const u32x2*)(vt + (dt * 16 + fr) * 200 + ((32 * i + 16 + fq * 4) ^ ((dt * 2 + (fr >> 3)) << 2)));
            vv.x = lo.x; vv.y = lo.y; vv.z = hi.x; vv.w = hi.y;
            const bf16x8 Vf = __builtin_bit_cast(bf16x8, vv);
            o0 = __builtin_amdgcn_mfma_f32_16x16x32_bf16(Vf, Pf[0][i], o0, 0, 0, 0);
            o1 = __builtin_amdgcn_mfma_f32_16x16x32_bf16(Vf, Pf[1][i], o1, 0, 0, 0);
        }
        u32x2 w0, w1; w0.x = pk2(o0[0], o0[1]); w0.y = pk2(o0[2], o0[3]); w1.x = pk2(o1[0], o1[1]); w1.y = pk2(o1[2], o1[3]);
        bf16_t* op = p.ybr + (size_t)(t0 + qh * 32 + fr) * 1536 + hq * 64 + dt * 16 + fq * 4;
        *(u32x2*)op = w0; *(u32x2*)(op + 16 * 1536) = w1;
    }
    __syncthreads();
}

DEVFN void sgu_item(KP p, int l, int item, bf16_t* vnT  ) {
    const int tid = opaque_tid(), lane = tid & 63, w = tid >> 6, fr = lane & 15, fq = lane >> 4;
    const int n = item >> 1, gp = item & 1, t0 = n * 128;
    const bf16_t* proj = p.proj;
    const int irow = w * 16 + fr;
    bf16x8 Wf[2][4]; float bias[2];
#pragma unroll
    for (int gg = 0; gg < 2; ++gg) {
        const int g = gp * 2 + gg;
        const float* wrow = p.w_sp + ((size_t)(l * 4 + g) * 128 + irow) * 128;
#pragma unroll
        for (int ks = 0; ks < 4; ++ks) {
            const f32x4 a = *(const f32x4*)(wrow + ks * 32 + fq * 8), b2 = *(const f32x4*)(wrow + ks * 32 + fq * 8 + 4);
            u32x4 w4; w4.x = pk2(a[0], a[1]); w4.y = pk2(a[2], a[3]); w4.z = pk2(b2[0], b2[1]); w4.w = pk2(b2[2], b2[3]);
            if ((ks >> 1) > (w >> 2)) w4 = (u32x4){0u, 0u, 0u, 0u};
            Wf[gg][ks] = __builtin_bit_cast(bf16x8, w4);
        }
        bias[gg] = p.b_sp[(l * 4 + g) * 128 + irow];
    }
    {
        const int j = tid >> 2, part = tid & 3;
        const bf16_t* rp = proj + (size_t)(t0 + j) * IN_DIM + COL_SV + part * 128;
        u32x4 raw[16];
#pragma unroll
        for (int i = 0; i < 16; ++i) raw[i] = *(const u32x4*)(rp + i * 8);
        float ss = 0.f;
#pragma unroll
        for (int i = 0; i < 16; ++i) { float v[8]; unpack8(raw[i], v);
#pragma unroll
            for (int q = 0; q < 8; ++q) ss += v[q] * v[q]; }
        ss += __shfl_xor(ss, 1); ss += __shfl_xor(ss, 2);
        const float rv = rsqrtf(ss * (1.f / 512.f) + EPS);
        if ((part >> 1) == gp) {
            const int cb = (part & 1) * 128;
#pragma unroll
            for (int i = 0; i < 16; ++i) { float v[8]; unpack8(raw[i], v);
#pragma unroll
                for (int q = 0; q < 8; q += 2) { const unsigned pk = pk2(v[q] * rv, v[q + 1] * rv); const int c = cb + i * 8 + q;
                    vnT[c * 136 + (j ^ ((i & 15) << 3))] = (bf16_t)(pk & 0xffffu); vnT[(c + 1) * 136 + (j ^ ((i & 15) << 3))] = (bf16_t)(pk >> 16); } }
        }
    }
    __syncthreads();
#pragma unroll
    for (int gg = 0; gg < 2; ++gg) {
        const int g = gp * 2 + gg;
        u32x2 uu[8];
#pragma unroll
        for (int ct = 0; ct < 8; ++ct) uu[ct] = *(const u32x2*)(proj + (size_t)(t0 + irow) * IN_DIM + COL_SU + g * 128 + ct * 16 + fq * 4);
#pragma unroll
        for (int ct = 0; ct < 8; ++ct) {
            f32x4 a = (f32x4){0.f, 0.f, 0.f, 0.f};
#pragma unroll
            for (int ks = 0; ks < 4; ++ks) {
                const bf16x8 Af = *(const bf16x8*)(vnT + (gg * 128 + ct * 16 + fr) * 136 + ((ks * 32 + fq * 8) ^ ((ct * 2 + (fr >> 3)) << 3)));
                a = __builtin_amdgcn_mfma_f32_16x16x32_bf16(Af, Wf[gg][ks], a, 0, 0, 0);
            }
            const int cc = g * 128 + ct * 16 + fq * 4;
            const f32x4 gs = *(const f32x4*)(p.g_sgu + l * 512 + cc);
            float u[4]; unpack4(uu[ct], u);
            u32x2 o; o.x = pk2(u[0] * (a[0] * gs[0] + bias[gg]), u[1] * (a[1] * gs[1] + bias[gg])); o.y = pk2(u[2] * (a[2] * gs[2] + bias[gg]), u[3] * (a[3] * gs[3] + bias[gg]));
            *(u32x2*)(p.ybr + (size_t)(t0 + irow) * 1536 + 512 + cc) = o;
        }
    }
    __syncthreads();
}

DEVFN void pool_item(KP p, int l, int item, bf16_t* raw  , bf16_t* pl  ) {
    const int tid = opaque_tid(), lane = tid & 63, w = tid >> 6, fr = lane & 15, fq = lane >> 4;
    const int n = item >> 2, gi = item & 3, t0 = n * 128, s0 = t0 & (SEQ - 1), win = 2 << gi;
    const bf16_t* proj = p.proj;
    bf16_t* wl = pl + 128 * 136;
    const bf16_t* wp = p.W + W_POOL + (size_t)gi * 128 * 128;
    for (int idx = tid; idx < 144 * 16; idx += 512) {
        const int r = idx >> 4, cgp = idx & 15;
        u32x4 v = (u32x4){0u, 0u, 0u, 0u};
        if (s0 - 16 + r >= 0) v = *(const u32x4*)(proj + (size_t)(t0 - 16 + r) * IN_DIM + COL_PC + gi * 128 + cgp * 8);
        *(u32x4*)(raw + r * 136 + cgp * 8) = v;
    }
    for (int idx = tid; idx < 128 * 16; idx += 512) {
        const int d = idx >> 4, cgp = idx & 15;
        *(u32x4*)(wl + d * 136 + cgp * 8) = *(const u32x4*)(wp + (size_t)d * 128 + cgp * 8);
    }
    __syncthreads();
    {
        const int cgp = tid & 15, tb = (tid >> 4) * 4;
        float sum[8] = {0.f, 0.f, 0.f, 0.f, 0.f, 0.f, 0.f, 0.f};
        for (int i = 1; i < win; ++i) {
            float v[8]; unpack8(*(const u32x4*)(raw + (16 + tb - i) * 136 + cgp * 8), v);
#pragma unroll
            for (int k = 0; k < 8; ++k) sum[k] += v[k];
        }
#pragma unroll
        for (int k4 = 0; k4 < 4; ++k4) {
            const int t = tb + k4;
            float cur[8]; unpack8(*(const u32x4*)(raw + (16 + t) * 136 + cgp * 8), cur);
#pragma unroll
            for (int k = 0; k < 8; ++k) sum[k] += cur[k];
            const int s = s0 + t; const float icnt = __builtin_amdgcn_rcpf((float)((s + 1) < win ? (s + 1) : win));
            u32x4 o; o.x = pk2(sum[0] * icnt - cur[0], sum[1] * icnt - cur[1]); o.y = pk2(sum[2] * icnt - cur[2], sum[3] * icnt - cur[3]);
            o.z = pk2(sum[4] * icnt - cur[4], sum[5] * icnt - cur[5]); o.w = pk2(sum[6] * icnt - cur[6], sum[7] * icnt - cur[7]);
            *(u32x4*)(pl + t * 136 + cgp * 8) = o;
            float old[8]; unpack8(*(const u32x4*)(raw + (16 + t + 1 - win) * 136 + cgp * 8), old);
#pragma unroll
            for (int k = 0; k < 8; ++k) sum[k] -= old[k];
        }
    }
    __syncthreads();
    f32x4 scv[8];
#pragma unroll
    for (int dt = 0; dt < 8; ++dt) scv[dt] = *(const f32x4*)(p.pool_scale + l * 512 + gi * 128 + dt * 16 + fq * 4);
    bf16x8 Bf[4];
#pragma unroll
    for (int ks = 0; ks < 4; ++ks) Bf[ks] = *(const bf16x8*)(pl + (w * 16 + fr) * 136 + ks * 32 + fq * 8);
#pragma unroll
    for (int dt = 0; dt < 8; ++dt) {
        f32x4 a = (f32x4){0.f, 0.f, 0.f, 0.f};
#pragma unroll
        for (int ks = 0; ks < 4; ++ks) {
            const bf16x8 Af = *(const bf16x8*)(wl + (dt * 16 + fr) * 136 + ks * 32 + fq * 8);
            a = __builtin_amdgcn_mfma_f32_16x16x32_bf16(Af, Bf[ks], a, 0, 0, 0);
        }
        const int dd = gi * 128 + dt * 16 + fq * 4;
        const f32x4 sc = scv[dt];
        u32x2 o; o.x = pk2(a[0] * sc[0], a[1] * sc[1]); o.y = pk2(a[2] * sc[2], a[3] * sc[3]);
        *(u32x2*)(p.ybr + (size_t)(t0 + w * 16 + fr) * 1536 + 1024 + dd) = o;
    }
    __syncthreads();
}

DEVFN void memattn_item(KP p, int l, int item, bf16_t* vt  ) {
    const int tid = opaque_tid(), lane = tid & 63, w = tid >> 6, fr = lane & 15, fq = lane >> 4;
    const int qt = item >> 2, h = item & 3, t0 = qt * 128, b = t0 / SEQ;
    const bf16_t* kv = p.kvm + (size_t)(b * 256) * KVLD + l * 1024;
    const bf16_t* qm = p.merged;
    bf16_t* om = p.merged + (size_t)T * 512;
    const int qrow = t0 + w * 16 + fr;
    bf16x8 Qf[4];
#pragma unroll
    for (int db = 0; db < 4; ++db) Qf[db] = *(const bf16x8*)(qm + (size_t)qrow * 512 + h * 128 + db * 32 + fq * 8);
    bf16_t* kl = vt + 128 * 264;
#pragma unroll
    for (int hb = 0; hb < 2; ++hb) {
        u32x4 rv[4], rk[4];
#pragma unroll
        for (int j = 0; j < 4; ++j) {
            const int idx = tid + 512 * (hb * 4 + j), key = idx >> 4, dg = idx & 15;
            rv[j] = *(const u32x4*)(kv + (size_t)key * KVLD + 512 + h * 128 + dg * 8); rk[j] = *(const u32x4*)(kv + (size_t)key * KVLD + h * 128 + dg * 8);
        }
#pragma unroll
        for (int j = 0; j < 4; ++j) {
            const int idx = tid + 512 * (hb * 4 + j), key = idx >> 4, dg = idx & 15;
            const unsigned ws[4] = {rv[j].x, rv[j].y, rv[j].z, rv[j].w};
#pragma unroll
            for (int i = 0; i < 4; ++i) { vt[(dg * 8 + 2 * i) * 264 + (key ^ (dg << 2))] = (bf16_t)(ws[i] & 0xffffu); vt[(dg * 8 + 2 * i + 1) * 264 + (key ^ (dg << 2))] = (bf16_t)(ws[i] >> 16); }
            *(u32x4*)(kl + key * 136 + dg * 8) = rk[j];
        }
    }
    __syncthreads();
    f32x4 s[16];
#pragma unroll
    for (int kt = 0; kt < 16; ++kt) {
        const bf16_t* kp = kl + (kt * 16 + fr) * 136 + fq * 8;
        f32x4 a = (f32x4){0.f, 0.f, 0.f, 0.f};
#pragma unroll
        for (int db = 0; db < 4; ++db) a = __builtin_amdgcn_mfma_f32_16x16x32_bf16(*(const bf16x8*)(kp + db * 32), Qf[db], a, 0, 0, 0);
        s[kt] = a;
    }
    float m = -1e30f;
#pragma unroll
    for (int kt = 0; kt < 16; ++kt) m = fmaxf(m, fmaxf(fmaxf(s[kt][0], s[kt][1]), fmaxf(s[kt][2], s[kt][3])));
    m = fmaxf(m, __shfl_xor(m, 16)); m = fmaxf(m, __shfl_xor(m, 32));
    float sum = 0.f;
#pragma unroll
    for (int kt = 0; kt < 16; ++kt)
#pragma unroll
        for (int j = 0; j < 4; ++j) { const float e = __expf(s[kt][j] - m); s[kt][j] = e; sum += e; }
    sum += __shfl_xor(sum, 16); sum += __shfl_xor(sum, 32);
    const float inv = __builtin_amdgcn_rcpf(sum);
    bf16x8 Pf[8];
#pragma unroll
    for (int i = 0; i < 8; ++i) {
        u32x4 w4;
        w4.x = pk2(s[2 * i][0] * inv, s[2 * i][1] * inv); w4.y = pk2(s[2 * i][2] * inv, s[2 * i][3] * inv);
        w4.z = pk2(s[2 * i + 1][0] * inv, s[2 * i + 1][1] * inv); w4.w = pk2(s[2 * i + 1][2] * inv, s[2 * i + 1][3] * inv);
        Pf[i] = __builtin_bit_cast(bf16x8, w4);
    }
#pragma unroll
    for (int dt = 0; dt < 8; ++dt) {
        f32x4 o = (f32x4){0.f, 0.f, 0.f, 0.f};
#pragma unroll
        for (int i = 0; i < 8; ++i) {
            const bf16_t* vp = vt + (dt * 16 + fr) * 264 + ((32 * i + fq * 4) ^ ((dt * 2 + (fr >> 3)) << 2));
            u32x4 vv; const u32x2 lo = *(const u32x2*)vp, hi = *(const u32x2*)(vt + (dt * 16 + fr) * 264 + ((32 * i + 16 + fq * 4) ^ ((dt * 2 + (fr >> 3)) << 2)));
            vv.x = lo.x; vv.y = lo.y; vv.z = hi.x; vv.w = hi.y;
            o = __builtin_amdgcn_mfma_f32_16x16x32_bf16(__builtin_bit_cast(bf16x8, vv), Pf[i], o, 0, 0, 0);
        }
        u32x2 ow; ow.x = pk2(o[0], o[1]); ow.y = pk2(o[2], o[3]);
        *(u32x2*)(om + (size_t)qrow * 512 + h * 128 + dt * 16 + fq * 4) = ow;
    }
    __syncthreads();
}


struct Seam { unsigned* bar; unsigned x, nx, npop; };
DEVFN unsigned xcc_id() { return (unsigned)__builtin_amdgcn_s_getreg((3 << 11) | 20) & 0xFu; }
DEVFN unsigned bar_ld(unsigned* p) { return __hip_atomic_load(p, __ATOMIC_RELAXED, __HIP_MEMORY_SCOPE_AGENT); }
DEVFN unsigned bar_add(unsigned* p) { return __hip_atomic_fetch_add(p, 1u, __ATOMIC_RELAXED, __HIP_MEMORY_SCOPE_AGENT); }
DEVFN void grid_seam(Seam& S) {
    asm volatile("s_waitcnt vmcnt(0)" ::: "memory");
    __syncthreads();
    if (threadIdx.x == 0) {
        __builtin_amdgcn_s_waitcnt(0);
        unsigned* bar = S.bar;
        const unsigned old = bar_add(bar + 64 * (16 + S.x));
        const unsigned gen = old / S.nx;
        if (old + 1u == (gen + 1u) * S.nx) {
            __builtin_amdgcn_fence(__ATOMIC_RELEASE, "agent");
            asm volatile("s_waitcnt vmcnt(0)" ::: "memory");
            const unsigned og = bar_add(bar + 64 * 48);
            const unsigned tg = og / S.npop;
            if (og + 1u == (tg + 1u) * S.npop) bar_add(bar + 64 * 49);
            else while (bar_ld(bar + 64 * 49) == tg) __builtin_amdgcn_s_sleep(1);
            __builtin_amdgcn_fence(__ATOMIC_ACQUIRE, "agent");
            bar_add(bar + 64 * (32 + S.x));
            asm volatile("s_waitcnt vmcnt(0)" ::: "memory");
        } else {
            while (bar_ld(bar + 64 * (32 + S.x)) == gen) __builtin_amdgcn_s_sleep(1);
            __builtin_amdgcn_fence(__ATOMIC_ACQUIRE, "agent");
            asm volatile("s_waitcnt vmcnt(0)" ::: "memory");
        }
    }
    __syncthreads();
}

constexpr int PH_PER_LAYER = 9, N_PHASES = 1 + PH_PER_LAYER * DEPTH;

DEVFN void run_phase(KP p, int ph, unsigned char* smem) {
    bf16_t* shm = (bf16_t*)smem;
    const int G = gridDim.x, bid = blockIdx.x;
    if (ph == 0) {
        prep_rows(p.x, nullptr, p.xb, p.rssq, true, T);
        prep_rows(p.mem, nullptr, p.memb, p.rmem, false, NMEM_ROWS);
        for (int l = 0; l < DEPTH; ++l) convert_mat(p.w_kv + (size_t)l * D * 1024, 1024, D, 1024, p.Wkv + (size_t)l * 1024 * 1024, p.g_mem + l * D, 0, 1.f, (float*)smem, bid, G);
        convert_set(p, 0, 1 | 2 | 4, (float*)smem, bid, G);
        return;
    }
    const int l = (ph - 1) / PH_PER_LAYER, k = (ph - 1) % PH_PER_LAYER;
    bf16_t* qm = p.merged;
    bf16_t* om = p.merged + (size_t)T * 512;
    bf16_t* ubuf = p.proj;
    if (k == 5) {
        for (int it = bid; it < 512; it += G) memattn_item(p, l, it, shm);
        if (l + 1 < DEPTH) convert_set(p, l + 1, 4, (float*)smem, bid, G);
        return;
    }
    pg8::Gemm g; g.A = p.xb; g.Bt = p.W; g.M = T; g.N = D; g.K = D; g.lda = D; g.asub = 0u; g.bsub = 0u;
    EpiRT E; E.mode = 0; E.out = nullptr; E.ldc = D; E.rowscale = nullptr; E.rs_mode = 0; E.act = 0; E.ssq = nullptr; E.gate = nullptr; E.first = true;
    E.after_drain = false; E.gidx = 0; E.want = 0u; E.pp = &p; E.i8 = 0; E.xs = p.xs; E.wcol = p.bar + WCOL_IN + (size_t)l * IN_DIM; E.rpar = 0;
    const float* rs_in = p.rssq + (size_t)((3 * l) & 1) * T * 4;
    int nsub = 1;
    switch (k) {
    case 0: g.Bt = p.W + W_IN; g.N = (l == 0) ? IN_DIM : IN_DIM - 256; E.out = p.proj; E.ldc = IN_DIM; E.rowscale = rs_in; E.rs_mode = 2; E.act = -1; nsub = (l == 0) ? 2 : 1;
        if (l > 0) { g.A = (const bf16_t*)p.merged; g.lda = 512; g.K = 512; E.i8 = 1; }
        break;
    case 1: g.Bt = p.W + W_IN + (size_t)(IN_DIM - 256) * 512; g.N = 256; E.out = p.proj + (IN_DIM - 256); E.ldc = IN_DIM; E.rowscale = rs_in; E.rs_mode = 2; E.act = 2; nsub = (l == 0) ? 0 : 1;
        g.A = (const bf16_t*)p.merged; g.lda = 512; g.K = 512; E.i8 = 1; E.wcol += IN_DIM - 256; break;
    case 2: g.A = p.ybr; g.lda = 1536; g.Bt = p.W + W_BR; g.K = 512; g.asub = 512u * 2u; g.bsub = (unsigned)(D * 512 * 2); E.mode = 1; E.out = p.merged; E.gate = p.proj + COL_GATE; break;
    case 3: g.A = p.merged; g.Bt = p.W + W_OUT; E.after_drain = true; E.gidx = l * 6 + 1; E.want = 16u * (unsigned)(l * 3 + 1); E.rpar = (3 * l + 1) & 1; break;
    case 4: g.Bt = p.W + W_Q; g.N = 512; E.out = qm; E.ldc = 512; E.rowscale = p.rssq + (size_t)((3 * l + 1) & 1) * T * 4; E.rs_mode = 2; break;
    case 6: g.A = om; g.lda = 512; g.K = 512; g.Bt = p.W + W_O; E.after_drain = true; E.gidx = l * 6 + 3; E.want = 16u * (unsigned)(l * 3 + 2); E.rpar = (3 * l + 2) & 1; break;
    case 7: g.A = (const bf16_t*)p.ybr; g.lda = 512; g.K = 512; g.Bt = p.W + W_UP; g.N = DFF; E.out = ubuf; E.ldc = DFF; E.rowscale = p.rssq + (size_t)((3 * l + 2) & 1) * T * 4; E.rs_mode = 2; E.act = 3; E.i8 = 1; E.wcol = p.bar + WCOL_UP + (size_t)l * DFF; break;
    case 8: g.A = ubuf; g.lda = DFF; g.K = DFF; g.Bt = p.W + W_DN; E.after_drain = true; E.gidx = l * 6 + 5; E.want = 16u * (unsigned)(l * 3 + 3); E.rpar = (3 * l + 3) & 1; break;
    default: break;
    }
    pg8::StaticOrder S; S.init(g.M, g.N, G, bid, k == 2 ? 3 : 1);
    for (int n = 0; n < nsub; ++n) {
        if (k == 0 && n == 1) {
            g.A = p.memb; g.Bt = p.Wkv; g.M = NMEM_ROWS; g.N = DEPTH * 1024; E.out = p.kvm; E.ldc = DEPTH * 1024; E.rowscale = p.rmem; E.rs_mode = 1; E.act = 0;
            S.init(g.M, g.N, G, (bid + G - 64) % G);
        }
        if (E.i8 && !(k == 0 && n == 1)) pg8::gemm_phase<EpiRT, pg8::StaticOrder, true, true, true>((PG8_LAS unsigned char*)smem, g, S, E);
        else pg8::gemm_phase<EpiRT, pg8::StaticOrder, true, true, false>((PG8_LAS unsigned char*)smem, g, S, E);
    }
    if (k == 1) {
        const int first = (l == 0) ? bid : (bid >= 64 ? bid - 64 : 1088 + bid), step = (l == 0) ? G : (bid >= 64 ? 192 : 64), limit = (l == 0 || bid < 64) ? 1280 : 1088;
        for (int it = first; it < limit; it += step) {
            if (it < 512) attn_item(p, l, it, shm);
            else if (it < 768) sgu_item(p, l, it - 512, shm);
            else pool_item(p, l, it - 768, shm, shm + 144 * 136);
        }
        const bool wlight = (l == 0) || bid < 64 || bid >= 192;
        const int wvb = (l == 0) ? bid : (bid < 64 ? bid : bid - 128), wnb = (l == 0) ? G : 128;
        if (wlight) {
            if (l + 1 < DEPTH) wabs_pass(p.w_in + (size_t)(l + 1) * D * IN_DIM, IN_DIM, p.g_norm + ((l + 1) * 6 + 0) * D, 512, p.bar + WCOL_IN + (size_t)(l + 1) * IN_DIM, wvb, wnb);
            wabs_pass(p.w_up + (size_t)l * D * DFF, DFF, p.g_norm + (l * 6 + 4) * D, 0, p.bar + WCOL_UP + (size_t)l * DFF, wvb, wnb);
        }
    }
    if (k == 4 && bid >= 128) {
        convert_set(p, l, 8, (float*)smem, bid - 128, G - 128);
        if (l + 1 < DEPTH) convert_set(p, l + 1, 1 | 2, (float*)smem, bid - 128, G - 128);
    }
}

constexpr int LDS_BYTES = 140 * 1024;

__global__ void __launch_bounds__(512, 2) fwd_kernel(Params p) {
    extern __shared__ __attribute__((aligned(16))) unsigned char smem[];
    if (p.ph_hi < 0) cg::this_grid().sync();
    Seam S; S.bar = p.bar; S.x = xcc_id(); S.nx = 1; S.npop = 1;
    if (threadIdx.x == 0) bar_add(S.bar + 64 * S.x);
    for (int ph = p.ph_lo; ph < p.ph_hi; ++ph) {
        KPtr pp = (KPtr)__builtin_amdgcn_kernarg_segment_ptr();
        asm volatile("" : "+s"(pp));
        run_phase(*pp, ph, smem);
#ifdef REPEAT_K
        if (ph >= 1 && ((REPEAT_K >> ((ph - 1) % PH_PER_LAYER)) & 1)) for (int rep = 0; rep < REPEAT_N; ++rep) { grid_seam(S); run_phase(*pp, ph, smem); }
#endif
#ifdef EXTRA_SYNCS
        if (ph >= 1 && (ph - 1) % PH_PER_LAYER == 0) for (int e = 0; e < EXTRA_SYNCS; ++e) grid_seam(S);
#endif
        if (ph + 1 < p.ph_hi) {
            if (ph == p.ph_lo && threadIdx.x == 0) {
                for (;;) {
                    unsigned sum = 0u, np = 0u, mine = 1u;
                    for (int j = 0; j < 16; ++j) { const unsigned c = bar_ld(S.bar + 64 * j); sum += c; np += c ? 1u : 0u; if (j == (int)S.x) mine = c; }
                    if (sum == gridDim.x) { S.nx = mine; S.npop = np; break; }
                    __builtin_amdgcn_s_sleep(1);
                }
            }
            grid_seam(S);
        }
    }
}

extern "C" void kernel_launch(void* const* d_in, const int* in_sizes, int n_in, void* d_out, int out_size, void* d_ws, size_t ws_size, hipStream_t stream) {
    static int grid = 0;
    if (grid == 0) {
        int dev = 0, cus = 0, per_cu = 0;
        hipGetDevice(&dev);
        hipDeviceGetAttribute(&cus, hipDeviceAttributeMultiprocessorCount, dev);
        hipFuncSetAttribute((const void*)fwd_kernel, hipFuncAttributeMaxDynamicSharedMemorySize, LDS_BYTES);
        hipOccupancyMaxActiveBlocksPerMultiprocessor(&per_cu, (const void*)fwd_kernel, 512, LDS_BYTES);
        if (per_cu < 1) per_cu = 1;
        grid = cus * 1;
        (void)hipGetLastError();
    }
    Params p{};
    const float* const* in = (const float* const*)d_in;
    p.x = in[0]; p.mem = in[1]; p.g_norm = in[2]; p.g_mem = in[3]; p.w_in = in[4]; p.sinks = in[5]; p.w_sp = in[6]; p.b_sp = in[7]; p.g_sgu = in[8];
    p.w_pool = in[9]; p.pool_scale = in[10]; p.w_branch = in[11]; p.w_out = in[12]; p.w_q = in[13]; p.w_kv = in[14]; p.w_o = in[15]; p.w_up = in[16]; p.w_down = in[17];
    p.xres = (float*)d_out;
    unsigned char* ws = (unsigned char*)d_ws;
    size_t off = 0;
    auto take = [&](size_t bytes) { unsigned char* r = ws + off; off += (bytes + 255) & ~(size_t)255; return r; };
    p.W = (bf16_t*)take(W_TOTAL * 2);
    p.proj = (bf16_t*)take((size_t)T * IN_DIM * 2);
    p.Wkv = (bf16_t*)take((size_t)DEPTH * 1024 * 1024 * 2);
    p.ybr = (bf16_t*)take((size_t)T * 1536 * 2);
    p.merged = (bf16_t*)take((size_t)T * D * 2);
    p.xb = (bf16_t*)take((size_t)T * D * 2);
    p.kvm = (bf16_t*)take((size_t)DEPTH * NMEM_ROWS * 1024 * 2);
    p.memb = (bf16_t*)take((size_t)NMEM_ROWS * D * 2);
    p.rssq = (float*)take((size_t)T * 16 * 2);
    p.xs = (float*)take((size_t)T * 4);
    p.rmem = (float*)take((size_t)NMEM_ROWS * 4);
    p.xslot = (float*)take((size_t)T * 16);
    p.bar = (unsigned*)take(136 * 256 + (size_t)DEPTH * (IN_DIM + DFF) * 4);
    if (off > ws_size) { fprintf(stderr, "kernel_launch: workspace too small: need %zu have %zu\n", off, ws_size); return; }
    hipMemsetAsync(p.bar, 0, 136 * 256 + (size_t)DEPTH * (IN_DIM + DFF) * 4, stream);
    p.ph_lo = 0; p.ph_hi = N_PHASES;
    void* args[] = {&p};
    hipError_t e = hipLaunchCooperativeKernel((const void*)fwd_kernel, dim3(grid), dim3(512), args, LDS_BYTES, stream);
    if (e != hipSuccess) fprintf(stderr, "cooperative launch failed: %s (grid %d)\n", hipGetErrorString(e), grid);
}
```

```cpp
#include <hip/hip_runtime.h>
#include <hip/hip_cooperative_groups.h>
#include <cstdio>
#include <cstdint>
namespace cg = cooperative_groups;


typedef unsigned short bf16_t;
typedef short bf16x8 __attribute__((ext_vector_type(8)));
typedef float f32x4 __attribute__((ext_vector_type(4)));
typedef unsigned u32x4 __attribute__((ext_vector_type(4)));
typedef unsigned u32x2 __attribute__((ext_vector_type(2)));
typedef int i32x4 __attribute__((ext_vector_type(4)));
#define DEVFN __device__ __forceinline__

constexpr int T = 16384, D = 1024, SEQ = 4096, DEPTH = 4, IN_DIM = 5376, DFF = 4096, NMEM_ROWS = 1024;
constexpr int COL_K = 512, COL_V = 640, COL_SU = 768, COL_SV = 1280, COL_PC = 1792, COL_GATE = 2304;
constexpr float EPS = 1e-6f;
constexpr int WCOL_IN = 64 * 136, WCOL_UP = WCOL_IN + 4 * 5376;
constexpr int KVLD = DEPTH * 1024;
constexpr size_t W_IN = 0, W_BR = W_IN + (size_t)IN_DIM * D, W_OUT = W_BR + 3ull * D * 512, W_Q = W_OUT + (size_t)D * D,
                 W_O = W_Q + 512ull * D, W_UP = W_O + (size_t)D * 512, W_DN = W_UP + (size_t)DFF * D, W_POOL = W_DN + (size_t)D * DFF,
                 W_TOTAL = W_POOL + 4ull * 128 * 128;

struct Params {
    const float *x, *mem, *g_norm, *g_mem, *w_in, *sinks, *w_sp, *b_sp, *g_sgu, *w_pool, *pool_scale, *w_branch, *w_out, *w_q, *w_kv, *w_o, *w_up, *w_down;
    float* xres;
    bf16_t *W, *Wkv, *proj, *ybr, *merged, *xb, *kvm, *memb;
    float *rssq, *rmem, *xslot, *xs;
    unsigned* bar;
    int ph_lo, ph_hi;
};

typedef const __attribute__((address_space(4))) Params* KPtr;
typedef const __attribute__((address_space(4))) Params& KP;
DEVFN int opaque_tid() { int t = threadIdx.x; asm volatile("" : "+v"(t)); return t; }
DEVFN float bf2f(unsigned b) { return __uint_as_float(b << 16); }
typedef float f32x2 __attribute__((ext_vector_type(2)));
typedef __bf16 bf16x2v __attribute__((ext_vector_type(2)));
DEVFN unsigned pk2(float lo, float hi) { const f32x2 v = {lo, hi}; return __builtin_bit_cast(unsigned, __builtin_convertvector(v, bf16x2v)); }
DEVFN float wave_sum(float v) {
#pragma unroll
    for (int o = 32; o; o >>= 1) v += __shfl_xor(v, o);
    return v;
}
DEVFN float gelu_tanh(float x) { const float u = 1.5957691216f * (x + 0.044715f * x * x * x); return x * __builtin_amdgcn_rcpf(1.f + __expf(-u)); }
DEVFN float sigmoidf(float x) { return __builtin_amdgcn_rcpf(1.f + __expf(-x)); }
DEVFN void unpack4(u32x2 w, float (&o)[4]) { o[0] = bf2f(w.x & 0xffffu); o[1] = bf2f(w.x >> 16); o[2] = bf2f(w.y & 0xffffu); o[3] = bf2f(w.y >> 16); }
DEVFN void unpack8(u32x4 w, float (&o)[8]) {
    o[0] = bf2f(w.x & 0xffffu); o[1] = bf2f(w.x >> 16); o[2] = bf2f(w.y & 0xffffu); o[3] = bf2f(w.y >> 16);
    o[4] = bf2f(w.z & 0xffffu); o[5] = bf2f(w.z >> 16); o[6] = bf2f(w.w & 0xffffu); o[7] = bf2f(w.w >> 16);
}

namespace pg8 {
#define PG8_LAS __attribute__((address_space(3)))
constexpr int BM = 256, BK = 64, HALF = 128, HTB = HALF * BK * 2, STAGE_BYTES = 8 * HTB, NXCD = 8, WGM = 8;
__host__ __device__ __forceinline__ int lds_byte(int r, int c) { const int st = (r >> 4) * 2 + (c >> 5), rr = r & 15, cc = c & 31, ob = rr * 64 + cc * 2; return st * 1024 + (ob ^ (((ob >> 9) & 1) << 5)); }
__host__ __device__ __forceinline__ void stage_rc(int b, int& R, int& C) { const int st = b / 1024, sb = b % 1024, swz = sb ^ (((sb >> 9) & 1) << 5); R = (st >> 1) * 16 + swz / 64; C = (st & 1) * 32 + (swz % 64) / 2; }
__host__ __device__ __forceinline__ int perm32(int rho) { const int n = rho >> 4, i = rho & 15; return 8 * (i >> 2) + 4 * n + (i & 3); }
struct Unit { int pm, pn, sub; };
struct Gemm { const bf16_t* A; const bf16_t* Bt; int M, N, K, lda; unsigned asub, bsub; };
struct StaticOrder {
    int nM, nN, nwg, G, c, nsubs;
    __host__ __device__ void init(int M, int N, int G_, int c_, int nsubs_ = 1) { nM = M / BM; nN = N / BM; nwg = nM * nN; G = G_; c = c_; nsubs = nsubs_; }
    __host__ __device__ bool next(int i, Unit& u) const {
        const int ti = i / nsubs; u.sub = i - ti * nsubs;
        const long L = (long)ti * G + c; if (L >= nwg) return false;
        int wgid = (int)L; { const int q = nwg / NXCD, r = nwg % NXCD, xcd = wgid % NXCD, off = wgid / NXCD; wgid = (xcd < r ? xcd * (q + 1) : r * (q + 1) + (xcd - r) * q) + off; }
        const int nig = WGM * nN, gid = wgid / nig, fm = gid * WGM, gsz = (nM - fm) < WGM ? (nM - fm) : WGM;
        u.pm = fm + ((wgid % nig) % gsz); u.pn = (wgid % nig) / gsz; return true;
    }
    __device__ __forceinline__ void a_ready(const Unit&) const {}
    __device__ __forceinline__ void done(const Unit&) const {}
};
template <class Epi, class Sched, bool ALIGN_EPI = false, bool SP2 = false, bool I8 = false>
__device__ __forceinline__ void gemm_phase(PG8_LAS unsigned char* lds, const Gemm g, const Sched& S, const Epi& E) {
    const int tid = opaque_tid(), wid = __builtin_amdgcn_readfirstlane(tid >> 6), lane = tid & 63, wr = wid >> 2, wc = wid & 3, fr = lane & 15, fq = lane >> 4;
    const int K = g.K, nt = K / BK;
    unsigned voffA[2], voffB[2];
#pragma unroll
    for (int i = 0; i < 2; ++i) { int R, C; stage_rc(tid * 16 + i * 8192, R, C); const int Rb = Epi::PERM ? ((R & ~31) + perm32(R & 31)) : R;
        voffA[i] = (unsigned)(R * g.lda + C) * 2u; voffB[i] = (unsigned)(Rb * K + C) * 2u; }
    const size_t kstep = (size_t)(BK * 2);
    const size_t hstepA = (size_t)HALF * g.lda * 2, hstepB = (size_t)HALF * K * 2;
    const size_t tstepA = 2 * hstepA, tstepB = 2 * hstepB;
    const unsigned ldsw = (unsigned)wid * 1024u;
    const int aoff = lds_byte(wr * 64 + fr, fq * 8), boff = lds_byte(wc * 32 + fr, fq * 8);
#define PG8_SA(b, h) (((b) * 2 + (h)) * HTB)
#define PG8_SB(b, h) ((4 + (b) * 2 + (h)) * HTB)
#define PG8_STAGE(bufoff, gbase, voff) do { _Pragma("unroll") for (int _i = 0; _i < 2; ++_i) \
        __builtin_amdgcn_global_load_lds((const unsigned*)((const char*)(gbase) + (voff)[_i]), (PG8_LAS unsigned*)(lds + (bufoff) + ldsw + _i * 8192), 16, 0, 0); } while (0)
#define PG8_LDA(dst, b, h) do { _Pragma("unroll") for (int m = 0; m < 4; ++m) _Pragma("unroll") for (int k = 0; k < 2; ++k) dst[m][k] = *(const PG8_LAS bf16x8*)(lds + PG8_SA(b, h) + aoff + m * 2048 + k * 1024); } while (0)
#define PG8_LDB(dst, b, h) do { _Pragma("unroll") for (int n = 0; n < 2; ++n) _Pragma("unroll") for (int k = 0; k < 2; ++k) dst[n][k] = *(const PG8_LAS bf16x8*)(lds + PG8_SB(b, h) + boff + n * 2048 + k * 1024); } while (0)
#define PG8_MMA(ai, bj, At, Bt) do { __builtin_amdgcn_s_setprio(1); _Pragma("unroll") for (int m = 0; m < 4; ++m) _Pragma("unroll") for (int n = 0; n < 2; ++n) _Pragma("unroll") for (int k = 0; k < 2; ++k) { \
        if constexpr (I8) acc[ai][bj][m][n] = __builtin_bit_cast(f32x4, __builtin_amdgcn_mfma_i32_16x16x64_i8(__builtin_bit_cast(i32x4, Bt[n][k]), __builtin_bit_cast(i32x4, At[m][k]), __builtin_bit_cast(i32x4, acc[ai][bj][m][n]), 0, 0, 0)); \
        else acc[ai][bj][m][n] = __builtin_amdgcn_mfma_f32_16x16x32_bf16(Bt[n][k], At[m][k], acc[ai][bj][m][n], 0, 0, 0); } __builtin_amdgcn_s_setprio(0); } while (0)
#define PG8_WAIT_V(n) asm volatile("s_waitcnt vmcnt(" #n ")" ::: "memory")
#define PG8_WAIT_L(n) asm volatile("s_waitcnt lgkmcnt(" #n ")" ::: "memory")
#define PG8_BAR __builtin_amdgcn_s_barrier()
#define PG8_SCHED __builtin_amdgcn_sched_barrier(0)
    Unit cur, nxt; int ui = 0;
    if (!S.next(0, cur)) return;
    f32x4 acc[2][2][4][2];
#pragma unroll
    for (int a = 0; a < 2; ++a)
#pragma unroll
        for (int b = 0; b < 2; ++b)
#pragma unroll
            for (int m = 0; m < 4; ++m)
#pragma unroll
                for (int n = 0; n < 2; ++n) acc[a][b][m][n] = (f32x4){0.f, 0.f, 0.f, 0.f};
    bf16x8 At[4][2], B0[2][2], B1[2][2];
    const char* cA = (const char*)g.A + (size_t)cur.pm * tstepA + (size_t)cur.sub * g.asub; const char* cB = (const char*)g.Bt + (size_t)cur.pn * tstepB + (size_t)cur.sub * g.bsub;
    S.a_ready(cur);
    if constexpr (SP2) {
        PG8_STAGE(PG8_SB(0, 0), cB, voffB); PG8_STAGE(PG8_SB(0, 1), cB + hstepB, voffB); PG8_STAGE(PG8_SA(0, 0), cA, voffA); PG8_STAGE(PG8_SA(0, 1), cA + hstepA, voffA);
        if (wr == 1) PG8_BAR;
        PG8_WAIT_V(2); PG8_BAR;
        PG8_STAGE(PG8_SB(1, 0), cB + kstep, voffB); PG8_STAGE(PG8_SA(1, 0), cA + kstep, voffA); PG8_STAGE(PG8_SB(1, 1), cB + hstepB + kstep, voffB);
        PG8_WAIT_V(6); PG8_BAR;
    } else {
        PG8_STAGE(PG8_SB(0, 0), cB, voffB); PG8_STAGE(PG8_SA(0, 0), cA, voffA); PG8_STAGE(PG8_SB(0, 1), cB + hstepB, voffB); PG8_STAGE(PG8_SA(0, 1), cA + hstepA, voffA);
        if (wr == 1) PG8_BAR;
        PG8_WAIT_V(4); PG8_BAR;
        PG8_STAGE(PG8_SB(1, 0), cB + kstep, voffB); PG8_STAGE(PG8_SA(1, 0), cA + kstep, voffA); PG8_STAGE(PG8_SB(1, 1), cB + hstepB + kstep, voffB);
        PG8_WAIT_V(6); PG8_BAR;
    }
    for (;;) {
        const bool has_next = S.next(ui + 1, nxt);
        const char* nA = has_next ? (const char*)g.A + (size_t)nxt.pm * tstepA + (size_t)nxt.sub * g.asub : cA; const char* nB = has_next ? (const char*)g.Bt + (size_t)nxt.pn * tstepB + (size_t)nxt.sub * g.bsub : cB;
        for (int t = 0; t < nt; t += 2) {
            const bool last = (t == nt - 2);
            const char* a1 = cA + (size_t)(t + 1) * kstep;
            const char* a2 = last ? nA : cA + (size_t)(t + 2) * kstep; const char* b2 = last ? nB : cB + (size_t)(t + 2) * kstep;
            const char* a3 = a2 + kstep; const char* b3 = b2 + kstep;
            if (last && has_next) S.a_ready(nxt);
            if constexpr (SP2) {
            PG8_LDB(B0, 0, 0); PG8_LDB(B1, 0, 1); PG8_SCHED; PG8_LDA(At, 0, 0); PG8_STAGE(PG8_SA(1, 1), a1 + hstepA, voffA);
            PG8_WAIT_V(8); PG8_WAIT_L(0); PG8_BAR; PG8_MMA(0, 0, At, B0); PG8_MMA(0, 1, At, B1); PG8_BAR; PG8_SCHED;
            PG8_LDA(At, 0, 1); PG8_STAGE(PG8_SB(0, 0), b2, voffB); PG8_STAGE(PG8_SB(0, 1), b2 + hstepB, voffB); PG8_STAGE(PG8_SA(0, 0), a2, voffA);
            PG8_WAIT_V(8); PG8_WAIT_L(0); PG8_BAR; PG8_MMA(1, 0, At, B0); PG8_MMA(1, 1, At, B1); PG8_BAR; PG8_SCHED;
            PG8_LDB(B0, 1, 0); PG8_LDB(B1, 1, 1); PG8_SCHED; PG8_LDA(At, 1, 0); PG8_STAGE(PG8_SA(0, 1), a2 + hstepA, voffA);
            PG8_WAIT_V(8); PG8_WAIT_L(0); PG8_BAR; PG8_MMA(0, 0, At, B0); PG8_MMA(0, 1, At, B1); PG8_BAR; PG8_SCHED;
            PG8_LDA(At, 1, 1); PG8_STAGE(PG8_SB(1, 0), b3, voffB); PG8_STAGE(PG8_SB(1, 1), b3 + hstepB, voffB); PG8_STAGE(PG8_SA(1, 0), a3, voffA);
            PG8_WAIT_V(8); PG8_WAIT_L(0); PG8_BAR; PG8_MMA(1, 0, At, B0); PG8_MMA(1, 1, At, B1); PG8_BAR; PG8_SCHED;
            } else {
            PG8_LDB(B0, 0, 0); PG8_SCHED; PG8_LDA(At, 0, 0); PG8_STAGE(PG8_SA(1, 1), a1 + hstepA, voffA);
            PG8_WAIT_L(8); PG8_BAR; PG8_WAIT_L(0); PG8_MMA(0, 0, At, B0); PG8_BAR; PG8_SCHED;
            PG8_LDB(B1, 0, 1); PG8_STAGE(PG8_SB(0, 0), b2, voffB);
            PG8_BAR; PG8_WAIT_L(0); PG8_MMA(0, 1, At, B1); PG8_BAR;
            PG8_LDA(At, 0, 1); PG8_STAGE(PG8_SA(0, 0), a2, voffA);
            PG8_BAR; PG8_WAIT_L(0); PG8_MMA(1, 0, At, B0); PG8_BAR; PG8_SCHED;
            PG8_STAGE(PG8_SB(0, 1), b2 + hstepB, voffB);
            PG8_WAIT_V(6); PG8_BAR; PG8_MMA(1, 1, At, B1); PG8_BAR;
            PG8_LDB(B0, 1, 0); PG8_SCHED; PG8_LDA(At, 1, 0); PG8_STAGE(PG8_SA(0, 1), a2 + hstepA, voffA);
            PG8_WAIT_L(8); PG8_BAR; PG8_WAIT_L(0); PG8_MMA(0, 0, At, B0); PG8_BAR; PG8_SCHED;
            PG8_LDB(B1, 1, 1); PG8_STAGE(PG8_SB(1, 0), b3, voffB);
            PG8_BAR; PG8_WAIT_L(0); PG8_MMA(0, 1, At, B1); PG8_BAR;
            PG8_LDA(At, 1, 1); PG8_STAGE(PG8_SA(1, 0), a3, voffA);
            PG8_BAR; PG8_WAIT_L(0); PG8_MMA(1, 0, At, B0); PG8_BAR; PG8_SCHED;
            PG8_STAGE(PG8_SB(1, 1), b3 + hstepB, voffB);
            PG8_WAIT_V(6); PG8_BAR; PG8_MMA(1, 1, At, B1); PG8_BAR;
            }
        }
        if constexpr (ALIGN_EPI) { if (wr == 0) PG8_BAR; }
        if (!E.after_drain) { E(acc, cur, wr, wc, fr, fq); S.done(cur); }
        if (!has_next) break;
#pragma unroll
        for (int a = 0; a < 2; ++a)
#pragma unroll
            for (int b = 0; b < 2; ++b)
#pragma unroll
                for (int m = 0; m < 4; ++m)
#pragma unroll
                    for (int n = 0; n < 2; ++n) acc[a][b][m][n] = (f32x4){0.f, 0.f, 0.f, 0.f};
        cur = nxt; cA = nA; cB = nB; ++ui;
        if constexpr (ALIGN_EPI) { if (wr == 1) PG8_BAR; }
    }
    PG8_WAIT_V(0);
    if constexpr (!ALIGN_EPI) { if (wr == 0) PG8_BAR; }
    PG8_BAR;
    if (E.after_drain) { E.fused(acc, cur, wr, wc, fr, fq, lds, wid, lane); S.done(cur); }
#undef PG8_SA
#undef PG8_SB
#undef PG8_STAGE
#undef PG8_LDA
#undef PG8_LDB
#undef PG8_MMA
#undef PG8_WAIT_V
#undef PG8_WAIT_L
#undef PG8_BAR
#undef PG8_SCHED
}
}

struct EpiRT {
    static constexpr bool PERM = true;
    int mode; bf16_t* out; int ldc; const float* rowscale; int rs_mode  ; int act; float* ssq; const bf16_t* gate; bool first;
    bool after_drain; int gidx; unsigned want; KPtr pp;
    int i8; const float* xs; const unsigned* wcol; int rpar;
    __device__ __forceinline__ void operator()(const f32x4 (&acc)[2][2][4][2], const pg8::Unit& u, int wr, int wc, int fr, int fq) const {
        const int bcol = u.pn * 256;
        const int row0 = u.pm * 256 + wr * 64 + fr, col0 = bcol + wc * 32 + 8 * fq;
        if (mode == 0) {
            int a = act; float* sq = ssq;
            if (act < 0) { a = (bcol >= COL_GATE) ? 2 : ((bcol >= COL_SU && bcol < COL_PC) ? 1 : 0); sq = (bcol >= COL_SV && bcol < COL_PC) ? ssq : nullptr; }
            float rsv[2][4]; u32x4 wc0[2], wc1[2];
            {
                f32x4 q[2][4]; float xv[2][4];
                if (rs_mode == 2) {
#pragma unroll
                    for (int ai = 0; ai < 2; ++ai)
#pragma unroll
                        for (int m = 0; m < 4; ++m) q[ai][m] = *(const f32x4*)(rowscale + 4 * (size_t)(row0 + ai * 128 + m * 16));
                } else if (rs_mode == 1) {
#pragma unroll
                    for (int ai = 0; ai < 2; ++ai)
#pragma unroll
                        for (int m = 0; m < 4; ++m) q[ai][m] = (f32x4){rowscale[row0 + ai * 128 + m * 16], 0.f, 0.f, 0.f};
                }
                if (i8) {
#pragma unroll
                    for (int ai = 0; ai < 2; ++ai)
#pragma unroll
                        for (int m = 0; m < 4; ++m) xv[ai][m] = xs[row0 + ai * 128 + m * 16];
#pragma unroll
                    for (int bj = 0; bj < 2; ++bj) { wc0[bj] = *(const u32x4*)(wcol + col0 + bj * 128); wc1[bj] = *(const u32x4*)(wcol + col0 + bj * 128 + 4); }
                }
#pragma unroll
                for (int ai = 0; ai < 2; ++ai)
#pragma unroll
                    for (int m = 0; m < 4; ++m) {
                        float rs = 1.f;
                        if (rs_mode == 1) rs = q[ai][m][0];
                        else if (rs_mode == 2) rs = rsqrtf(((q[ai][m][0] + q[ai][m][1]) + (q[ai][m][2] + q[ai][m][3])) * (1.f / D) + EPS);
                        if (i8) rs *= xv[ai][m] * (1.f / 127.f);
                        rsv[ai][m] = rs;
                    }
            }
#pragma unroll
            for (int ai = 0; ai < 2; ++ai)
#pragma unroll
                for (int m = 0; m < 4; ++m) {
                    const int row = row0 + ai * 128 + m * 16;
                    const float rs = rsv[ai][m];
                    float ss = 0.f;
                    bf16_t* orow = out + (size_t)row * ldc + col0;
#pragma unroll
                    for (int bj = 0; bj < 2; ++bj) {
                        float v[8];
#pragma unroll
                        for (int j = 0; j < 4; ++j) {
                            const float a0 = i8 ? (float)__float_as_int(acc[ai][bj][m][0][j]) : acc[ai][bj][m][0][j], a1 = i8 ? (float)__float_as_int(acc[ai][bj][m][1][j]) : acc[ai][bj][m][1][j];
                            v[j] = a0 * rs; v[4 + j] = a1 * rs; }
                        if (i8) {
                            const u32x4 c0 = wc0[bj], c1 = wc1[bj];
                            v[0] *= __uint_as_float(c0.x); v[1] *= __uint_as_float(c0.y); v[2] *= __uint_as_float(c0.z); v[3] *= __uint_as_float(c0.w);
                            v[4] *= __uint_as_float(c1.x); v[5] *= __uint_as_float(c1.y); v[6] *= __uint_as_float(c1.z); v[7] *= __uint_as_float(c1.w);
                        }
                        if (a == 1) {
#pragma unroll
                            for (int j = 0; j < 8; ++j) v[j] = gelu_tanh(v[j]);
                        } else if (a == 2) {
#pragma unroll
                            for (int j = 0; j < 8; ++j) v[j] = sigmoidf(v[j]);
                        } else if (a == 3) {
#pragma unroll
                            for (int j = 0; j < 8; ++j) { const float t = fmaxf(v[j], 0.f); v[j] = t * t; }
                        }
                        u32x4 w; w.x = pk2(v[0], v[1]); w.y = pk2(v[2], v[3]); w.z = pk2(v[4], v[5]); w.w = pk2(v[6], v[7]);
                        *(u32x4*)(orow + bj * 128) = w;
                    }
                }
        } else {
#pragma unroll
            for (int ai = 0; ai < 2; ++ai)
#pragma unroll
              for (int mh = 0; mh < 2; ++mh) {
                u32x4 gv[2][2], pq[2][2];
#pragma unroll
                for (int mm = 0; mm < 2; ++mm)
#pragma unroll
                    for (int bj = 0; bj < 2; ++bj) gv[mm][bj] = *(const u32x4*)(gate + (size_t)(row0 + ai * 128 + (mh * 2 + mm) * 16) * IN_DIM + u.sub * D + col0 + bj * 128);
                if (u.sub != 0) {
#pragma unroll
                    for (int mm = 0; mm < 2; ++mm)
#pragma unroll
                        for (int bj = 0; bj < 2; ++bj) pq[mm][bj] = *(const u32x4*)(out + (size_t)(row0 + ai * 128 + (mh * 2 + mm) * 16) * D + col0 + bj * 128);
                }
#pragma unroll
                for (int mm = 0; mm < 2; ++mm) {
                    const int m = mh * 2 + mm;
                    const int row = row0 + ai * 128 + m * 16;
#pragma unroll
                    for (int bj = 0; bj < 2; ++bj) {
                        const int col = col0 + bj * 128;
                        float g[8]; unpack8(gv[mm][bj], g);
                        float v[8];
#pragma unroll
                        for (int j = 0; j < 4; ++j) { v[j] = acc[ai][bj][m][0][j] * g[j]; v[4 + j] = acc[ai][bj][m][1][j] * g[4 + j]; }
                        bf16_t* mp = out + (size_t)row * D + col;
                        if (u.sub != 0) { float pv[8]; unpack8(pq[mm][bj], pv);
#pragma unroll
                            for (int j = 0; j < 8; ++j) v[j] += pv[j]; }
                        u32x4 w; w.x = pk2(v[0], v[1]); w.y = pk2(v[2], v[3]); w.z = pk2(v[4], v[5]); w.w = pk2(v[6], v[7]);
                        *(u32x4*)mp = w;
                    }
                }
              }
        }
    }

    __device__ __forceinline__ void fused(f32x4 (&acc)[2][2][4][2], const pg8::Unit& u, int wr, int wc, int fr, int fq, PG8_LAS unsigned char* lds, int wid, int lane) const {
        PG8_LAS float* P = (PG8_LAS float*)lds;
        PG8_LAS float* Sr = (PG8_LAS float*)(lds + 4096);
        const int tid = wid * 64 + lane;
        KPtr q_ = pp; asm volatile("" : "+s"(q_));
        float* const x = q_->xres; bf16_t* const xb = q_->xb; float* const rssq = q_->rssq + (size_t)rpar * T * 4; const float* const rssq_old = q_->rssq + (size_t)(rpar ^ 1) * T * 4; float* const xslot = q_->xslot;
        signed char* const xq = (gidx % 6) == 3 ? (signed char*)q_->ybr : (signed char*)q_->merged; float* const xsp = q_->xs;
        unsigned* const pcnt = q_->bar + 64 * 64; const float* const gvec = q_->g_norm + gidx * D;
        const bool last = gidx == (DEPTH - 1) * 6 + 5;
        const bool quant = ((gidx % 6) == 5 && !last) || (gidx % 6) == 3;
        PG8_LAS float* Sq = (PG8_LAS float*)(lds + 4096 + 1024);
        const int col0 = u.pn * 256 + wc * 32 + 8 * fq;
        u32x4 xv[2][4][2]; f32x4 gq[2][2];
#pragma unroll
        for (int ai = 0; ai < 2; ++ai)
#pragma unroll
            for (int m = 0; m < 4; ++m) {
                float s = 0.f;
#pragma unroll
                for (int bj = 0; bj < 2; ++bj)
#pragma unroll
                    for (int n = 0; n < 2; ++n) { const f32x4 v = acc[ai][bj][m][n]; s += (v[0] * v[0] + v[1] * v[1]) + (v[2] * v[2] + v[3] * v[3]); }
                s += __shfl_xor(s, 16); s += __shfl_xor(s, 32);
                if (fq == 0) P[(ai * 128 + wr * 64 + m * 16 + fr) * 4 + wc] = s;
            }
        asm volatile("s_waitcnt lgkmcnt(0)" ::: "memory"); __builtin_amdgcn_s_barrier(); asm volatile("" ::: "memory");
        unsigned* slots = (unsigned*)xslot + (size_t)(u.pm * 256) * 4;
        if (tid < 256) {
            const float t = (P[tid * 4 + 0] + P[tid * 4 + 1]) + (P[tid * 4 + 2] + P[tid * 4 + 3]);
            __hip_atomic_store(slots + tid * 4 + u.pn, __float_as_uint(t), __ATOMIC_RELAXED, __HIP_MEMORY_SCOPE_AGENT);
        }
        asm volatile("s_waitcnt vmcnt(0)" ::: "memory");
        if (tid < 256 && lane == 0) __hip_atomic_fetch_add(pcnt + 64 * u.pm, 1u, __ATOMIC_RELAXED, __HIP_MEMORY_SCOPE_AGENT);
#pragma unroll
        for (int ai = 0; ai < 2; ++ai)
#pragma unroll
            for (int m = 0; m < 4; ++m)
#pragma unroll
                for (int bj = 0; bj < 2; ++bj) xv[ai][m][bj] = *(const u32x4*)(xb + (size_t)(u.pm * 256 + ai * 128 + wr * 64 + m * 16 + fr) * D + col0 + bj * 128);
#pragma unroll
        for (int bj = 0; bj < 2; ++bj) { gq[bj][0] = *(const f32x4*)(gvec + col0 + bj * 128); gq[bj][1] = *(const f32x4*)(gvec + col0 + bj * 128 + 4); }
        if (wid == 0) {
            while ((unsigned)__builtin_amdgcn_readfirstlane(__hip_atomic_load(pcnt + 64 * u.pm, __ATOMIC_RELAXED, __HIP_MEMORY_SCOPE_AGENT)) < want) __builtin_amdgcn_s_sleep(1);
        }
        asm volatile("s_waitcnt vmcnt(0) lgkmcnt(0)" ::: "memory"); __builtin_amdgcn_s_barrier(); asm volatile("" ::: "memory");
        if (tid < 256) {
            float t = 0.f;
#pragma unroll
            for (int q = 0; q < 4; ++q) t += __uint_as_float(__hip_atomic_load(slots + tid * 4 + q, __ATOMIC_RELAXED, __HIP_MEMORY_SCOPE_AGENT));
            Sr[tid] = rsqrtf(t * (1.f / D) + EPS);
            if (quant) {
                const f32x4 q4 = *(const f32x4*)(rssq_old + (size_t)(u.pm * 256 + tid) * 4);
                const float step = 5.5f * sqrtf(((q4[0] + q4[1]) + (q4[2] + q4[3])) * (1.f / D) + 1.0f) * (1.f / 127.f);
                Sq[tid] = __builtin_amdgcn_rcpf(step);
                if (u.pn == 0) xsp[u.pm * 256 + tid] = step;
            }
        }
        asm volatile("s_waitcnt lgkmcnt(0)" ::: "memory"); __builtin_amdgcn_s_barrier(); asm volatile("" ::: "memory");
#pragma unroll
        for (int ai = 0; ai < 2; ++ai)
#pragma unroll
            for (int m = 0; m < 4; ++m) {
                const int r = ai * 128 + wr * 64 + m * 16 + fr;
                const float ry = Sr[r];
                const size_t off = (size_t)(u.pm * 256 + r) * D + col0;
                float s2 = 0.f;
#pragma unroll
                for (int bj = 0; bj < 2; ++bj) {
                    float xo[8]; unpack8(xv[ai][m][bj], xo);
                    const f32x4 g0 = gq[bj][0], g1 = gq[bj][1];
                    const f32x4 v0 = (f32x4){xo[0], xo[1], xo[2], xo[3]} + acc[ai][bj][m][0] * ry * g0, v1 = (f32x4){xo[4], xo[5], xo[6], xo[7]} + acc[ai][bj][m][1] * ry * g1;
                    u32x4 w; w.x = pk2(v0[0], v0[1]); w.y = pk2(v0[2], v0[3]); w.z = pk2(v1[0], v1[1]); w.w = pk2(v1[2], v1[3]);
                    float vr[8]; unpack8(w, vr);
                    s2 += (vr[0] * vr[0] + vr[1] * vr[1]) + (vr[2] * vr[2] + vr[3] * vr[3]) + (vr[4] * vr[4] + vr[5] * vr[5]) + (vr[6] * vr[6] + vr[7] * vr[7]);
                    *(u32x4*)(xb + off + bj * 128) = w;
                    if (last) { *(f32x4*)(x + off + bj * 128) = v0; *(f32x4*)(x + off + bj * 128 + 4) = v1; }
                    if (quant) {
                        const float is = Sq[r]; unsigned b[8];
#pragma unroll
                        for (int j = 0; j < 8; ++j) { int qv = __float2int_rn(vr[j] * is); qv = qv > 127 ? 127 : (qv < -127 ? -127 : qv); b[j] = (unsigned)qv & 255u; }
                        u32x2 qw; qw.x = b[0] | (b[1] << 8) | (b[2] << 16) | (b[3] << 24); qw.y = b[4] | (b[5] << 8) | (b[6] << 16) | (b[7] << 24);
                        *(u32x2*)(xq + off + bj * 128) = qw;
                    }
                }
                s2 += __shfl_xor(s2, 16); s2 += __shfl_xor(s2, 32);
                if (fq == 0) P[r * 4 + wc] = s2;
            }
        asm volatile("s_waitcnt lgkmcnt(0)" ::: "memory"); __builtin_amdgcn_s_barrier(); asm volatile("" ::: "memory");
        if (tid < 256) rssq[(size_t)(u.pm * 256 + tid) * 4 + u.pn] = (P[tid * 4 + 0] + P[tid * 4 + 1]) + (P[tid * 4 + 2] + P[tid * 4 + 3]);
        asm volatile("s_waitcnt lgkmcnt(0)" ::: "memory"); __builtin_amdgcn_s_barrier(); asm volatile("" ::: "memory");
    }
};

DEVFN void prep_rows(const float* __restrict__ src, float* dst, bf16_t* dstb, float* r, bool partials, int nrows) {
    const int tid = opaque_tid(), lane = tid & 63, gw = blockIdx.x * 8 + (tid >> 6), nw = gridDim.x * 8;
    f32x4 cur[4], nxt[4];
    int row = gw;
    if (row < nrows) {
#pragma unroll
        for (int i = 0; i < 4; ++i) cur[i] = *(const f32x4*)(src + (size_t)row * D + i * 256 + lane * 4);
    }
    while (row < nrows) {
        const int rn = row + nw;
        if (rn < nrows) {
#pragma unroll
            for (int i = 0; i < 4; ++i) nxt[i] = *(const f32x4*)(src + (size_t)rn * D + i * 256 + lane * 4);
        }
        float ss = 0.f;
#pragma unroll
        for (int i = 0; i < 4; ++i) {
            const size_t o = (size_t)row * D + i * 256 + lane * 4;
            const f32x4 v = cur[i];
            ss += (v[0] * v[0] + v[1] * v[1]) + (v[2] * v[2] + v[3] * v[3]);
            if (dst) *(f32x4*)(dst + o) = v;
            u32x2 w; w.x = pk2(v[0], v[1]); w.y = pk2(v[2], v[3]);
            *(u32x2*)(dstb + o) = w;
        }
        ss = wave_sum(ss);
        if (lane == 0) { if (partials) *(f32x4*)(r + 4 * (size_t)row) = (f32x4){ss, 0.f, 0.f, 0.f}; else r[row] = rsqrtf(ss * (1.f / D) + EPS); }
#pragma unroll
        for (int i = 0; i < 4; ++i) cur[i] = nxt[i];
        row = rn;
    }
}
DEVFN void convert_mat(const float* __restrict__ src, int src_ld, int K, int N, bf16_t* dst, const float* gvec, int qcols, float qscale, float* tile, int vb, int nb) {
    const int tn = N / 64, ntiles = (K / 64) * tn, tid = opaque_tid();
    const int r0 = tid >> 4, c4 = (tid & 15) * 4;
    f32x4 va, vb4; float sa = 1.f, sb = 1.f;
    int t = vb;
    if (t < ntiles) {
        const int k0 = (t / tn) * 64, n0 = (t % tn) * 64;
        va = *(const f32x4*)(src + (size_t)(k0 + r0) * src_ld + n0 + c4); vb4 = *(const f32x4*)(src + (size_t)(k0 + r0 + 32) * src_ld + n0 + c4);
        if (gvec) { sa = gvec[k0 + r0]; sb = gvec[k0 + r0 + 32]; }
    }
    while (t < ntiles) {
        const int k0 = (t / tn) * 64, n0 = (t % tn) * 64;
        tile[r0 * 65 + c4 + 0] = va[0] * sa; tile[r0 * 65 + c4 + 1] = va[1] * sa; tile[r0 * 65 + c4 + 2] = va[2] * sa; tile[r0 * 65 + c4 + 3] = va[3] * sa;
        tile[(r0 + 32) * 65 + c4 + 0] = vb4[0] * sb; tile[(r0 + 32) * 65 + c4 + 1] = vb4[1] * sb; tile[(r0 + 32) * 65 + c4 + 2] = vb4[2] * sb; tile[(r0 + 32) * 65 + c4 + 3] = vb4[3] * sb;
        const int tnx = t + nb;
        if (tnx < ntiles) {
            const int k1 = (tnx / tn) * 64, n1 = (tnx % tn) * 64;
            va = *(const f32x4*)(src + (size_t)(k1 + r0) * src_ld + n1 + c4); vb4 = *(const f32x4*)(src + (size_t)(k1 + r0 + 32) * src_ld + n1 + c4);
            if (gvec) { sa = gvec[k1 + r0]; sb = gvec[k1 + r0 + 32]; }
        }
        __syncthreads();
        {
            const int n = tid >> 3, kg = tid & 7;
            const float sc = (n0 + n < qcols) ? qscale : 1.f;
            float v[8];
#pragma unroll
            for (int i = 0; i < 8; ++i) v[i] = tile[(kg * 8 + i) * 65 + n] * sc;
            u32x4 w; w.x = pk2(v[0], v[1]); w.y = pk2(v[2], v[3]); w.z = pk2(v[4], v[5]); w.w = pk2(v[6], v[7]);
            *(u32x4*)(dst + (size_t)(n0 + n) * K + k0 + kg * 8) = w;
        }
        __syncthreads();
        t = tnx;
    }
}
DEVFN void convert_w_i8(const float* __restrict__ src, int N, const float* gvec, int qcols, const unsigned* wcol, signed char* dst, float* tile, int vb, int nb) {
    const int tn = N / 64, ntiles = (D / 64) * tn, tid = opaque_tid();
    const int r0 = tid >> 4, c4 = (tid & 15) * 4;
    f32x4 va, vb4; float sa = 1.f, sb = 1.f;
    int t = vb;
    if (t < ntiles) {
        const int k0 = (t / tn) * 64, n0 = (t % tn) * 64;
        va = *(const f32x4*)(src + (size_t)(k0 + r0) * N + n0 + c4); vb4 = *(const f32x4*)(src + (size_t)(k0 + r0 + 32) * N + n0 + c4);
        sa = gvec[k0 + r0]; sb = gvec[k0 + r0 + 32];
    }
    while (t < ntiles) {
        const int k0 = (t / tn) * 64, n0 = (t % tn) * 64;
        tile[r0 * 65 + c4 + 0] = va[0] * sa; tile[r0 * 65 + c4 + 1] = va[1] * sa; tile[r0 * 65 + c4 + 2] = va[2] * sa; tile[r0 * 65 + c4 + 3] = va[3] * sa;
        tile[(r0 + 32) * 65 + c4 + 0] = vb4[0] * sb; tile[(r0 + 32) * 65 + c4 + 1] = vb4[1] * sb; tile[(r0 + 32) * 65 + c4 + 2] = vb4[2] * sb; tile[(r0 + 32) * 65 + c4 + 3] = vb4[3] * sb;
        const int tnx = t + nb;
        if (tnx < ntiles) {
            const int k1 = (tnx / tn) * 64, n1 = (tnx % tn) * 64;
            va = *(const f32x4*)(src + (size_t)(k1 + r0) * N + n1 + c4); vb4 = *(const f32x4*)(src + (size_t)(k1 + r0 + 32) * N + n1 + c4);
            sa = gvec[k1 + r0]; sb = gvec[k1 + r0 + 32];
        }
        __syncthreads();
        {
            const int n = tid >> 3, kg = tid & 7;
            const float sc = ((n0 + n < qcols) ? 0.125f : 1.f) * 127.f * __builtin_amdgcn_rcpf(fmaxf(__uint_as_float(wcol[n0 + n]), 1e-30f));
            unsigned b[8];
#pragma unroll
            for (int i = 0; i < 8; ++i) { int qv = __float2int_rn(tile[(kg * 8 + i) * 65 + n] * sc); qv = qv > 127 ? 127 : (qv < -127 ? -127 : qv); b[i] = (unsigned)qv & 255u; }
            u32x2 w; w.x = b[0] | (b[1] << 8) | (b[2] << 16) | (b[3] << 24); w.y = b[4] | (b[5] << 8) | (b[6] << 16) | (b[7] << 24);
            *(u32x2*)(dst + (size_t)(n0 + n) * D + k0 + kg * 8) = w;
        }
        __syncthreads();
        t = tnx;
    }
}
DEVFN void wabs_pass(const float* __restrict__ src, int N, const float* gvec, int qcols, unsigned* wcol, int vb, int nb) {
    const int tid = opaque_tid();
    const int idx = vb * 512 + tid, cg4 = idx % (N / 4), ks = idx / (N / 4);
    const int rows = (D * (N / 4) + nb * 512 - 1) / (nb * 512) + 1;
    const int k0 = ks * rows, k1 = (k0 + rows) < D ? (k0 + rows) : D;
    if (k0 < D) {
        f32x4 m = (f32x4){0.f, 0.f, 0.f, 0.f};
        for (int kb = k0; kb < k1; kb += 4) {
            f32x4 v[4]; float s[4];
#pragma unroll
            for (int j = 0; j < 4; ++j) { const int k = (kb + j) < k1 ? (kb + j) : (k1 - 1); v[j] = *(const f32x4*)(src + (size_t)k * N + cg4 * 4); s[j] = fabsf(gvec[k]); }
#pragma unroll
            for (int j = 0; j < 4; ++j) { m[0] = fmaxf(m[0], fabsf(v[j][0]) * s[j]); m[1] = fmaxf(m[1], fabsf(v[j][1]) * s[j]); m[2] = fmaxf(m[2], fabsf(v[j][2]) * s[j]); m[3] = fmaxf(m[3], fabsf(v[j][3]) * s[j]); }
        }
        const float f = (cg4 * 4 < qcols) ? 0.125f : 1.f;
#pragma unroll
        for (int j = 0; j < 4; ++j) atomicMax(wcol + cg4 * 4 + j, __float_as_uint(m[j] * f));
    }
}

DEVFN void convert_set(KP p, int l, int mask, float* tile, int vb, int nb) {
    if (mask & 1) { if (l == 0) convert_mat(p.w_in + (size_t)l * D * IN_DIM, IN_DIM, D, IN_DIM, p.W + W_IN, p.g_norm + (l * 6 + 0) * D, 512, 0.125f, tile, vb, nb); else convert_w_i8(p.w_in + (size_t)l * D * IN_DIM, IN_DIM, p.g_norm + (l * 6 + 0) * D, 512, p.bar + WCOL_IN + (size_t)l * IN_DIM, (signed char*)(p.W + W_IN), tile, vb, nb); }
    if (mask & 2) {
        for (int g = 0; g < 4; ++g) convert_mat(p.w_pool + ((size_t)l * 4 + g) * 128 * 128, 128, 128, 128, p.W + W_POOL + (size_t)g * 128 * 128, nullptr, 0, 1.f, tile, vb, nb);
        for (int n = 0; n < 3; ++n) convert_mat(p.w_branch + ((size_t)l * 3 + n) * 512 * D, D, 512, D, p.W + W_BR + (size_t)n * D * 512, nullptr, 0, 1.f, tile, vb, nb);
        convert_mat(p.w_out + (size_t)l * D * D, D, D, D, p.W + W_OUT, nullptr, 0, 1.f, tile, vb, nb);
    }
    if (mask & 4) convert_mat(p.w_q + (size_t)l * D * 512, 512, D, 512, p.W + W_Q, p.g_norm + (l * 6 + 2) * D, 512, 0.08838834764831845f, tile, vb, nb);
    if (mask & 8) {
        convert_mat(p.w_o + (size_t)l * 512 * D, D, 512, D, p.W + W_O, nullptr, 0, 1.f, tile, vb, nb);
        convert_w_i8(p.w_up + (size_t)l * D * DFF, DFF, p.g_norm + (l * 6 + 4) * D, 0, p.bar + WCOL_UP + (size_t)l * DFF, (signed char*)(p.W + W_UP), tile, vb, nb);
        convert_mat(p.w_down + (size_t)l * DFF * D, D, DFF, D, p.W + W_DN, nullptr, 0, 1.f, tile, vb, nb);
    }
}

DEVFN void attn_item(KP p, int l, int item, bf16_t* vt  ) {
    const int tid = opaque_tid(), lane = tid & 63, w = tid >> 6, fr = lane & 15, fq = lane >> 4;
    const int b = item >> 7, c = (item >> 1) & 63, kvh = item & 1;
    const int t0 = b * SEQ + c * 64;
    const bf16_t* proj = p.proj;
    const int g = w >> 1, qh = w & 1, hq = kvh * 4 + g;
    const float sink = p.sinks[l * 8 + hq];
    bf16x8 Qf[2][2];
#pragma unroll
    for (int qt = 0; qt < 2; ++qt)
#pragma unroll
        for (int db = 0; db < 2; ++db)
            Qf[qt][db] = *(const bf16x8*)(proj + (size_t)(t0 + qh * 32 + qt * 16 + fr) * IN_DIM + hq * 64 + db * 32 + fq * 8);
    for (int idx = tid; idx < 192 * 8; idx += 512) {
        const int key = idx >> 3, dg = idx & 7;
        const bool valid = (c * 64 - 128 + key) >= 0;
        u32x4 raw = (u32x4){0u, 0u, 0u, 0u};
        if (valid) raw = *(const u32x4*)(proj + (size_t)(t0 - 128 + key) * IN_DIM + COL_V + kvh * 64 + dg * 8);
        const unsigned ws[4] = {raw.x, raw.y, raw.z, raw.w};
#pragma unroll
        for (int i = 0; i < 4; ++i) { vt[(dg * 8 + 2 * i) * 200 + (key ^ (dg << 2))] = (bf16_t)(ws[i] & 0xffffu); vt[(dg * 8 + 2 * i + 1) * 200 + (key ^ (dg << 2))] = (bf16_t)(ws[i] >> 16); }
    }
    bf16_t* kl = vt + 64 * 200;
    for (int idx = tid; idx < 192 * 8; idx += 512) {
        const int key = idx >> 3, dg = idx & 7;
        u32x4 raw = (u32x4){0u, 0u, 0u, 0u};
        if ((c * 64 - 128 + key) >= 0) raw = *(const u32x4*)(proj + (size_t)(t0 - 128 + key) * IN_DIM + COL_K + kvh * 64 + dg * 8);
        *(u32x4*)(kl + key * 72 + dg * 8) = raw;
    }
    __syncthreads();
    f32x4 s[12][2];
    const int kt_start = c >= 2 ? 0 : (2 - c) * 4;
#pragma unroll
    for (int kt = 0; kt < 12; ++kt) {
        if (kt >= kt_start) {
            const bf16_t* kp = kl + (kt * 16 + fr) * 72 + fq * 8;
            const bf16x8 k0 = *(const bf16x8*)kp, k1 = *(const bf16x8*)(kp + 32);
#pragma unroll
            for (int qt = 0; qt < 2; ++qt) {
                f32x4 a = (f32x4){0.f, 0.f, 0.f, 0.f};
                a = __builtin_amdgcn_mfma_f32_16x16x32_bf16(k0, Qf[qt][0], a, 0, 0, 0);
                a = __builtin_amdgcn_mfma_f32_16x16x32_bf16(k1, Qf[qt][1], a, 0, 0, 0);
                s[kt][qt] = a;
            }
        } else {
            s[kt][0] = (f32x4){-1e30f, -1e30f, -1e30f, -1e30f}; s[kt][1] = s[kt][0];
        }
    }
    bf16x8 Pf[2][6];
#pragma unroll
    for (int qt = 0; qt < 2; ++qt) {
        float m = sink;
#pragma unroll
        for (int kt = 0; kt < 12; ++kt) m = fmaxf(m, fmaxf(fmaxf(s[kt][qt][0], s[kt][qt][1]), fmaxf(s[kt][qt][2], s[kt][qt][3])));
        m = fmaxf(m, __shfl_xor(m, 16)); m = fmaxf(m, __shfl_xor(m, 32));
        float sum = 0.f;
#pragma unroll
        for (int kt = 0; kt < 12; ++kt) {
#pragma unroll
            for (int j = 0; j < 4; ++j) { const float e = __expf(s[kt][qt][j] - m); s[kt][qt][j] = e; sum += e; }
        }
        sum += __shfl_xor(sum, 16); sum += __shfl_xor(sum, 32);
        sum += __expf(sink - m);
        const float inv = __builtin_amdgcn_rcpf(sum);
#pragma unroll
        for (int i = 0; i < 6; ++i) {
            u32x4 w4;
            w4.x = pk2(s[2 * i][qt][0] * inv, s[2 * i][qt][1] * inv); w4.y = pk2(s[2 * i][qt][2] * inv, s[2 * i][qt][3] * inv);
            w4.z = pk2(s[2 * i + 1][qt][0] * inv, s[2 * i + 1][qt][1] * inv); w4.w = pk2(s[2 * i + 1][qt][2] * inv, s[2 * i + 1][qt][3] * inv);
            Pf[qt][i] = __builtin_bit_cast(bf16x8, w4);
        }
    }
#pragma unroll
    for (int dt = 0; dt < 4; ++dt) {
        f32x4 o0 = (f32x4){0.f, 0.f, 0.f, 0.f}, o1 = o0;
#pragma unroll
        for (int i = 0; i < 6; ++i) {
            const bf16_t* vp = vt + (dt * 16 + fr) * 200 + ((32 * i + fq * 4) ^ ((dt * 2 + (fr >> 3)) << 2));
            u32x4 vv; const u32x2 lo = *(const u32x2*)vp, hi = *(const u32x2*)(vt + (dt * 16 + fr) * 200 + ((32 * i + 16 + fq * 4) ^ ((dt * 2 + (fr >> 3)) << 2)));
            vv.x = lo.x; vv.y = lo.y; vv.z = hi.x; vv.w = hi.y;
            const bf16x8 Vf = __builtin_bit_cast(bf16x8, vv);
            o0 = __builtin_amdgcn_mfma_f32_16x16x32_bf16(Vf, Pf[0][i], o0, 0, 0, 0);
            o1 = __builtin_amdgcn_mfma_f32_16x16x32_bf16(Vf, Pf[1][i], o1, 0, 0, 0);
        }
        u32x2 w0, w1; w0.x = pk2(o0[0], o0[1]); w0.y = pk2(o0[2], o0[3]); w1.x = pk2(o1[0], o1[1]); w1.y = pk2(o1[2], o1[3]);
        bf16_t* op = p.ybr + (size_t)(t0 + qh * 32 + fr) * 1536 + hq * 64 + dt * 16 + fq * 4;
        *(u32x2*)op = w0; *(u32x2*)(op + 16 * 1536) = w1;
    }
    __syncthreads();
}

DEVFN void sgu_item(KP p, int l, int item, bf16_t* vnT  ) {
    const int tid = opaque_tid(), lane = tid & 63, w = tid >> 6, fr = lane & 15, fq = lane >> 4;
    const int n = item >> 1, gp = item & 1, t0 = n * 128;
    const bf16_t* proj = p.proj;
    const int irow = w * 16 + fr;
    bf16x8 Wf[2][4]; float bias[2];
#pragma unroll
    for (int gg = 0; gg < 2; ++gg) {
        const int g = gp * 2 + gg;
        const float* wrow = p.w_sp + ((size_t)(l * 4 + g) * 128 + irow) * 128;
#pragma unroll
        for (int ks = 0; ks < 4; ++ks) {
            const f32x4 a = *(const f32x4*)(wrow + ks * 32 + fq * 8), b2 = *(const f32x4*)(wrow + ks * 32 + fq * 8 + 4);
            u32x4 w4; w4.x = pk2(a[0], a[1]); w4.y = pk2(a[2], a[3]); w4.z = pk2(b2[0], b2[1]); w4.w = pk2(b2[2], b2[3]);
            if ((ks >> 1) > (w >> 2)) w4 = (u32x4){0u, 0u, 0u, 0u};
            Wf[gg][ks] = __builtin_bit_cast(bf16x8, w4);
        }
        bias[gg] = p.b_sp[(l * 4 + g) * 128 + irow];
    }
    {
        const int j = tid >> 2, part = tid & 3;
        const bf16_t* rp = proj + (size_t)(t0 + j) * IN_DIM + COL_SV + part * 128;
        u32x4 raw[16];
#pragma unroll
        for (int i = 0; i < 16; ++i) raw[i] = *(const u32x4*)(rp + i * 8);
        float ss = 0.f;
#pragma unroll
        for (int i = 0; i < 16; ++i) { float v[8]; unpack8(raw[i], v);
#pragma unroll
            for (int q = 0; q < 8; ++q) ss += v[q] * v[q]; }
        ss += __shfl_xor(ss, 1); ss += __shfl_xor(ss, 2);
        const float rv = rsqrtf(ss * (1.f / 512.f) + EPS);
        if ((part >> 1) == gp) {
            const int cb = (part & 1) * 128;
#pragma unroll
            for (int i = 0; i < 16; ++i) { float v[8]; unpack8(raw[i], v);
#pragma unroll
                for (int q = 0; q < 8; q += 2) { const unsigned pk = pk2(v[q] * rv, v[q + 1] * rv); const int c = cb + i * 8 + q;
                    vnT[c * 136 + (j ^ ((i & 15) << 3))] = (bf16_t)(pk & 0xffffu); vnT[(c + 1) * 136 + (j ^ ((i & 15) << 3))] = (bf16_t)(pk >> 16); } }
        }
    }
    __syncthreads();
#pragma unroll
    for (int gg = 0; gg < 2; ++gg) {
        const int g = gp * 2 + gg;
        u32x2 uu[8];
#pragma unroll
        for (int ct = 0; ct < 8; ++ct) uu[ct] = *(const u32x2*)(proj + (size_t)(t0 + irow) * IN_DIM + COL_SU + g * 128 + ct * 16 + fq * 4);
#pragma unroll
        for (int ct = 0; ct < 8; ++ct) {
            f32x4 a = (f32x4){0.f, 0.f, 0.f, 0.f};
#pragma unroll
            for (int ks = 0; ks < 4; ++ks) {
                const bf16x8 Af = *(const bf16x8*)(vnT + (gg * 128 + ct * 16 + fr) * 136 + ((ks * 32 + fq * 8) ^ ((ct * 2 + (fr >> 3)) << 3)));
                a = __builtin_amdgcn_mfma_f32_16x16x32_bf16(Af, Wf[gg][ks], a, 0, 0, 0);
            }
            const int cc = g * 128 + ct * 16 + fq * 4;
            const f32x4 gs = *(const f32x4*)(p.g_sgu + l * 512 + cc);
            float u[4]; unpack4(uu[ct], u);
            u32x2 o; o.x = pk2(u[0] * (a[0] * gs[0] + bias[gg]), u[1] * (a[1] * gs[1] + bias[gg])); o.y = pk2(u[2] * (a[2] * gs[2] + bias[gg]), u[3] * (a[3] * gs[3] + bias[gg]));
            *(u32x2*)(p.ybr + (size_t)(t0 + irow) * 1536 + 512 + cc) = o;
        }
    }
    __syncthreads();
}

DEVFN void pool_item(KP p, int l, int item, bf16_t* raw  , bf16_t* pl  ) {
    const int tid = opaque_tid(), lane = tid & 63, w = tid >> 6, fr = lane & 15, fq = lane >> 4;
    const int n = item >> 2, gi = item & 3, t0 = n * 128, s0 = t0 & (SEQ - 1), win = 2 << gi;
    const bf16_t* proj = p.proj;
    bf16_t* wl = pl + 128 * 136;
    const bf16_t* wp = p.W + W_POOL + (size_t)gi * 128 * 128;
    for (int idx = tid; idx < 144 * 16; idx += 512) {
        const int r = idx >> 4, cgp = idx & 15;
        u32x4 v = (u32x4){0u, 0u, 0u, 0u};
        if (s0 - 16 + r >= 0) v = *(const u32x4*)(proj + (size_t)(t0 - 16 + r) * IN_DIM + COL_PC + gi * 128 + cgp * 8);
        *(u32x4*)(raw + r * 136 + cgp * 8) = v;
    }
    for (int idx = tid; idx < 128 * 16; idx += 512) {
        const int d = idx >> 4, cgp = idx & 15;
        *(u32x4*)(wl + d * 136 + cgp * 8) = *(const u32x4*)(wp + (size_t)d * 128 + cgp * 8);
    }
    __syncthreads();
    {
        const int cgp = tid & 15, tb = (tid >> 4) * 4;
        float sum[8] = {0.f, 0.f, 0.f, 0.f, 0.f, 0.f, 0.f, 0.f};
        for (int i = 1; i < win; ++i) {
            float v[8]; unpack8(*(const u32x4*)(raw + (16 + tb - i) * 136 + cgp * 8), v);
#pragma unroll
            for (int k = 0; k < 8; ++k) sum[k] += v[k];
        }
#pragma unroll
        for (int k4 = 0; k4 < 4; ++k4) {
            const int t = tb + k4;
            float cur[8]; unpack8(*(const u32x4*)(raw + (16 + t) * 136 + cgp * 8), cur);
#pragma unroll
            for (int k = 0; k < 8; ++k) sum[k] += cur[k];
            const int s = s0 + t; const float icnt = __builtin_amdgcn_rcpf((float)((s + 1) < win ? (s + 1) : win));
            u32x4 o; o.x = pk2(sum[0] * icnt - cur[0], sum[1] * icnt - cur[1]); o.y = pk2(sum[2] * icnt - cur[2], sum[3] * icnt - cur[3]);
            o.z = pk2(sum[4] * icnt - cur[4], sum[5] * icnt - cur[5]); o.w = pk2(sum[6] * icnt - cur[6], sum[7] * icnt - cur[7]);
            *(u32x4*)(pl + t * 136 + cgp * 8) = o;
            float old[8]; unpack8(*(const u32x4*)(raw + (16 + t + 1 - win) * 136 + cgp * 8), old);
#pragma unroll
            for (int k = 0; k < 8; ++k) sum[k] -= old[k];
        }
    }
    __syncthreads();
    f32x4 scv[8];
#pragma unroll
    for (int dt = 0; dt < 8; ++dt) scv[dt] = *(const f32x4*)(p.pool_scale + l * 512 + gi * 128 + dt * 16 + fq * 4);
    bf16x8 Bf[4];
#pragma unroll
    for (int ks = 0; ks < 4; ++ks) Bf[ks] = *(const bf16x8*)(pl + (w * 16 + fr) * 136 + ks * 32 + fq * 8);
#pragma unroll
    for (int dt = 0; dt < 8; ++dt) {
        f32x4 a = (f32x4){0.f, 0.f, 0.f, 0.f};
#pragma unroll
        for (int ks = 0; ks < 4; ++ks) {
            const bf16x8 Af = *(const bf16x8*)(wl + (dt * 16 + fr) * 136 + ks * 32 + fq * 8);
            a = __builtin_amdgcn_mfma_f32_16x16x32_bf16(Af, Bf[ks], a, 0, 0, 0);
        }
        const int dd = gi * 128 + dt * 16 + fq * 4;
        const f32x4 sc = scv[dt];
        u32x2 o; o.x = pk2(a[0] * sc[0], a[1] * sc[1]); o.y = pk2(a[2] * sc[2], a[3] * sc[3]);
        *(u32x2*)(p.ybr + (size_t)(t0 + w * 16 + fr) * 1536 + 1024 + dd) = o;
    }
    __syncthreads();
}

DEVFN void memattn_item(KP p, int l, int item, bf16_t* vt  ) {
    const int tid = opaque_tid(), lane = tid & 63, w = tid >> 6, fr = lane & 15, fq = lane >> 4;
    const int qt = item >> 2, h = item & 3, t0 = qt * 128, b = t0 / SEQ;
    const bf16_t* kv = p.kvm + (size_t)(b * 256) * KVLD + l * 1024;
    const bf16_t* qm = p.merged;
    bf16_t* om = p.merged + (size_t)T * 512;
    const int qrow = t0 + w * 16 + fr;
    bf16x8 Qf[4];
#pragma unroll
    for (int db = 0; db < 4; ++db) Qf[db] = *(const bf16x8*)(qm + (size_t)qrow * 512 + h * 128 + db * 32 + fq * 8);
    bf16_t* kl = vt + 128 * 264;
    for (int idx = tid; idx < 256 * 16; idx += 512) {
        const int key = idx >> 4, dg = idx & 15;
        const u32x4 raw = *(const u32x4*)(kv + (size_t)key * KVLD + 512 + h * 128 + dg * 8);
        const unsigned ws[4] = {raw.x, raw.y, raw.z, raw.w};
#pragma unroll
        for (int i = 0; i < 4; ++i) { vt[(dg * 8 + 2 * i) * 264 + (key ^ (dg << 2))] = (bf16_t)(ws[i] & 0xffffu); vt[(dg * 8 + 2 * i + 1) * 264 + (key ^ (dg << 2))] = (bf16_t)(ws[i] >> 16); }
        *(u32x4*)(kl + key * 136 + dg * 8) = *(const u32x4*)(kv + (size_t)key * KVLD + h * 128 + dg * 8);
    }
    __syncthreads();
    f32x4 s[16];
#pragma unroll
    for (int kt = 0; kt < 16; ++kt) {
        const bf16_t* kp = kl + (kt * 16 + fr) * 136 + fq * 8;
        f32x4 a = (f32x4){0.f, 0.f, 0.f, 0.f};
#pragma unroll
        for (int db = 0; db < 4; ++db) a = __builtin_amdgcn_mfma_f32_16x16x32_bf16(*(const bf16x8*)(kp + db * 32), Qf[db], a, 0, 0, 0);
        s[kt] = a;
    }
    float m = -1e30f;
#pragma unroll
    for (int kt = 0; kt < 16; ++kt) m = fmaxf(m, fmaxf(fmaxf(s[kt][0], s[kt][1]), fmaxf(s[kt][2], s[kt][3])));
    m = fmaxf(m, __shfl_xor(m, 16)); m = fmaxf(m, __shfl_xor(m, 32));
    float sum = 0.f;
#pragma unroll
    for (int kt = 0; kt < 16; ++kt)
#pragma unroll
        for (int j = 0; j < 4; ++j) { const float e = __expf(s[kt][j] - m); s[kt][j] = e; sum += e; }
    sum += __shfl_xor(sum, 16); sum += __shfl_xor(sum, 32);
    const float inv = __builtin_amdgcn_rcpf(sum);
    bf16x8 Pf[8];
#pragma unroll
    for (int i = 0; i < 8; ++i) {
        u32x4 w4;
        w4.x = pk2(s[2 * i][0] * inv, s[2 * i][1] * inv); w4.y = pk2(s[2 * i][2] * inv, s[2 * i][3] * inv);
        w4.z = pk2(s[2 * i + 1][0] * inv, s[2 * i + 1][1] * inv); w4.w = pk2(s[2 * i + 1][2] * inv, s[2 * i + 1][3] * inv);
        Pf[i] = __builtin_bit_cast(bf16x8, w4);
    }
#pragma unroll
    for (int dt = 0; dt < 8; ++dt) {
        f32x4 o = (f32x4){0.f, 0.f, 0.f, 0.f};
#pragma unroll
        for (int i = 0; i < 8; ++i) {
            const bf16_t* vp = vt + (dt * 16 + fr) * 264 + ((32 * i + fq * 4) ^ ((dt * 2 + (fr >> 3)) << 2));
            u32x4 vv; const u32x2 lo = *(const u32x2*)vp, hi = *(const u32x2*)(vt + (dt * 16 + fr) * 264 + ((32 * i + 16 + fq * 4) ^ ((dt * 2 + (fr >> 3)) << 2)));
            vv.x = lo.x; vv.y = lo.y; vv.z = hi.x; vv.w = hi.y;
            o = __builtin_amdgcn_mfma_f32_16x16x32_bf16(__builtin_bit_cast(bf16x8, vv), Pf[i], o, 0, 0, 0);
        }
        u32x2 ow; ow.x = pk2(o[0], o[1]); ow.y = pk2(o[2], o[3]);
        *(u32x2*)(om + (size_t)qrow * 512 + h * 128 + dt * 16 + fq * 4) = ow;
    }
    __syncthreads();
}


struct Seam { unsigned* bar; unsigned x, nx, npop; };
DEVFN unsigned xcc_id() { return (unsigned)__builtin_amdgcn_s_getreg((3 << 11) | 20) & 0xFu; }
DEVFN unsigned bar_ld(unsigned* p) { return __hip_atomic_load(p, __ATOMIC_RELAXED, __HIP_MEMORY_SCOPE_AGENT); }
DEVFN unsigned bar_add(unsigned* p) { return __hip_atomic_fetch_add(p, 1u, __ATOMIC_RELAXED, __HIP_MEMORY_SCOPE_AGENT); }
DEVFN void grid_seam(Seam& S) {
    asm volatile("s_waitcnt vmcnt(0)" ::: "memory");
    __syncthreads();
    if (threadIdx.x == 0) {
        __builtin_amdgcn_s_waitcnt(0);
        unsigned* bar = S.bar;
        const unsigned old = bar_add(bar + 64 * (16 + S.x));
        const unsigned gen = old / S.nx;
        if (old + 1u == (gen + 1u) * S.nx) {
            __builtin_amdgcn_fence(__ATOMIC_RELEASE, "agent");
            asm volatile("s_waitcnt vmcnt(0)" ::: "memory");
            const unsigned og = bar_add(bar + 64 * 48);
            const unsigned tg = og / S.npop;
            if (og + 1u == (tg + 1u) * S.npop) bar_add(bar + 64 * 49);
            else while (bar_ld(bar + 64 * 49) == tg) __builtin_amdgcn_s_sleep(1);
            __builtin_amdgcn_fence(__ATOMIC_ACQUIRE, "agent");
            bar_add(bar + 64 * (32 + S.x));
            asm volatile("s_waitcnt vmcnt(0)" ::: "memory");
        } else {
            while (bar_ld(bar + 64 * (32 + S.x)) == gen) __builtin_amdgcn_s_sleep(1);
            __builtin_amdgcn_fence(__ATOMIC_ACQUIRE, "agent");
            asm volatile("s_waitcnt vmcnt(0)" ::: "memory");
        }
    }
    __syncthreads();
}

constexpr int PH_PER_LAYER = 9, N_PHASES = 1 + PH_PER_LAYER * DEPTH;

DEVFN void run_phase(KP p, int ph, unsigned char* smem) {
    bf16_t* shm = (bf16_t*)smem;
    const int G = gridDim.x, bid = blockIdx.x;
    if (ph == 0) {
        prep_rows(p.x, nullptr, p.xb, p.rssq, true, T);
        prep_rows(p.mem, nullptr, p.memb, p.rmem, false, NMEM_ROWS);
        for (int l = 0; l < DEPTH; ++l) convert_mat(p.w_kv + (size_t)l * D * 1024, 1024, D, 1024, p.Wkv + (size_t)l * 1024 * 1024, p.g_mem + l * D, 0, 1.f, (float*)smem, bid, G);
        convert_set(p, 0, 1 | 2 | 4, (float*)smem, bid, G);
        return;
    }
    const int l = (ph - 1) / PH_PER_LAYER, k = (ph - 1) % PH_PER_LAYER;
    bf16_t* qm = p.merged;
    bf16_t* om = p.merged + (size_t)T * 512;
    bf16_t* ubuf = p.proj;
    if (k == 5) {
        for (int it = bid; it < 512; it += G) memattn_item(p, l, it, shm);
        if (l + 1 < DEPTH) convert_set(p, l + 1, 4, (float*)smem, bid, G);
        return;
    }
    pg8::Gemm g; g.A = p.xb; g.Bt = p.W; g.M = T; g.N = D; g.K = D; g.lda = D; g.asub = 0u; g.bsub = 0u;
    EpiRT E; E.mode = 0; E.out = nullptr; E.ldc = D; E.rowscale = nullptr; E.rs_mode = 0; E.act = 0; E.ssq = nullptr; E.gate = nullptr; E.first = true;
    E.after_drain = false; E.gidx = 0; E.want = 0u; E.pp = &p; E.i8 = 0; E.xs = p.xs; E.wcol = p.bar + WCOL_IN + (size_t)l * IN_DIM; E.rpar = 0;
    const float* rs_in = p.rssq + (size_t)((3 * l) & 1) * T * 4;
    int nsub = 1;
    switch (k) {
    case 0: g.Bt = p.W + W_IN; g.N = (l == 0) ? IN_DIM : IN_DIM - 256; E.out = p.proj; E.ldc = IN_DIM; E.rowscale = rs_in; E.rs_mode = 2; E.act = -1; nsub = (l == 0) ? 2 : 1;
        if (l > 0) { g.A = (const bf16_t*)p.merged; g.lda = 512; g.K = 512; E.i8 = 1; }
        break;
    case 1: g.Bt = p.W + W_IN + (size_t)(IN_DIM - 256) * 512; g.N = 256; E.out = p.proj + (IN_DIM - 256); E.ldc = IN_DIM; E.rowscale = rs_in; E.rs_mode = 2; E.act = 2; nsub = (l == 0) ? 0 : 1;
        g.A = (const bf16_t*)p.merged; g.lda = 512; g.K = 512; E.i8 = 1; E.wcol += IN_DIM - 256; break;
    case 2: g.A = p.ybr; g.lda = 1536; g.Bt = p.W + W_BR; g.K = 512; g.asub = 512u * 2u; g.bsub = (unsigned)(D * 512 * 2); E.mode = 1; E.out = p.merged; E.gate = p.proj + COL_GATE; break;
    case 3: g.A = p.merged; g.Bt = p.W + W_OUT; E.after_drain = true; E.gidx = l * 6 + 1; E.want = 16u * (unsigned)(l * 3 + 1); E.rpar = (3 * l + 1) & 1; break;
    case 4: g.Bt = p.W + W_Q; g.N = 512; E.out = qm; E.ldc = 512; E.rowscale = p.rssq + (size_t)((3 * l + 1) & 1) * T * 4; E.rs_mode = 2; break;
    case 6: g.A = om; g.lda = 512; g.K = 512; g.Bt = p.W + W_O; E.after_drain = true; E.gidx = l * 6 + 3; E.want = 16u * (unsigned)(l * 3 + 2); E.rpar = (3 * l + 2) & 1; break;
    case 7: g.A = (const bf16_t*)p.ybr; g.lda = 512; g.K = 512; g.Bt = p.W + W_UP; g.N = DFF; E.out = ubuf; E.ldc = DFF; E.rowscale = p.rssq + (size_t)((3 * l + 2) & 1) * T * 4; E.rs_mode = 2; E.act = 3; E.i8 = 1; E.wcol = p.bar + WCOL_UP + (size_t)l * DFF; break;
    case 8: g.A = ubuf; g.lda = DFF; g.K = DFF; g.Bt = p.W + W_DN; E.after_drain = true; E.gidx = l * 6 + 5; E.want = 16u * (unsigned)(l * 3 + 3); E.rpar = (3 * l + 3) & 1; break;
    default: break;
    }
    pg8::StaticOrder S; S.init(g.M, g.N, G, bid, k == 2 ? 3 : 1);
    for (int n = 0; n < nsub; ++n) {
        if (k == 0 && n == 1) {
            g.A = p.memb; g.Bt = p.Wkv; g.M = NMEM_ROWS; g.N = DEPTH * 1024; E.out = p.kvm; E.ldc = DEPTH * 1024; E.rowscale = p.rmem; E.rs_mode = 1; E.act = 0;
            S.init(g.M, g.N, G, (bid + G - 64) % G);
        }
        if (E.i8 && !(k == 0 && n == 1)) pg8::gemm_phase<EpiRT, pg8::StaticOrder, true, true, true>((PG8_LAS unsigned char*)smem, g, S, E);
        else pg8::gemm_phase<EpiRT, pg8::StaticOrder, true, true, false>((PG8_LAS unsigned char*)smem, g, S, E);
    }
    if (k == 1) {
        const int first = (l == 0) ? bid : (bid >= 64 ? bid - 64 : 1088 + bid), step = (l == 0) ? G : (bid >= 64 ? 192 : 64), limit = (l == 0 || bid < 64) ? 1280 : 1088;
        for (int it = first; it < limit; it += step) {
            if (it < 512) attn_item(p, l, it, shm);
            else if (it < 768) sgu_item(p, l, it - 512, shm);
            else pool_item(p, l, it - 768, shm, shm + 144 * 136);
        }
        const bool wlight = (l == 0) || bid < 64 || bid >= 192;
        const int wvb = (l == 0) ? bid : (bid < 64 ? bid : bid - 128), wnb = (l == 0) ? G : 128;
        if (wlight) {
            if (l + 1 < DEPTH) wabs_pass(p.w_in + (size_t)(l + 1) * D * IN_DIM, IN_DIM, p.g_norm + ((l + 1) * 6 + 0) * D, 512, p.bar + WCOL_IN + (size_t)(l + 1) * IN_DIM, wvb, wnb);
            wabs_pass(p.w_up + (size_t)l * D * DFF, DFF, p.g_norm + (l * 6 + 4) * D, 0, p.bar + WCOL_UP + (size_t)l * DFF, wvb, wnb);
        }
    }
    if (k == 4 && bid >= 128) {
        convert_set(p, l, 8, (float*)smem, bid - 128, G - 128);
        if (l + 1 < DEPTH) convert_set(p, l + 1, 1 | 2, (float*)smem, bid - 128, G - 128);
    }
}

constexpr int LDS_BYTES = 140 * 1024;

__global__ void __launch_bounds__(512, 2) fwd_kernel(Params p) {
    extern __shared__ __attribute__((aligned(16))) unsigned char smem[];
    if (p.ph_hi < 0) cg::this_grid().sync();
    Seam S; S.bar = p.bar; S.x = xcc_id(); S.nx = 1; S.npop = 1;
    if (threadIdx.x == 0) bar_add(S.bar + 64 * S.x);
    for (int ph = p.ph_lo; ph < p.ph_hi; ++ph) {
        KPtr pp = (KPtr)__builtin_amdgcn_kernarg_segment_ptr();
        asm volatile("" : "+s"(pp));
        run_phase(*pp, ph, smem);
#ifdef REPEAT_K
        if (ph >= 1 && ((REPEAT_K >> ((ph - 1) % PH_PER_LAYER)) & 1)) for (int rep = 0; rep < REPEAT_N; ++rep) { grid_seam(S); run_phase(*pp, ph, smem); }
#endif
#ifdef EXTRA_SYNCS
        if (ph >= 1 && (ph - 1) % PH_PER_LAYER == 0) for (int e = 0; e < EXTRA_SYNCS; ++e) grid_seam(S);
#endif
        if (ph + 1 < p.ph_hi) {
            if (ph == p.ph_lo && threadIdx.x == 0) {
                for (;;) {
                    unsigned sum = 0u, np = 0u, mine = 1u;
                    for (int j = 0; j < 16; ++j) { const unsigned c = bar_ld(S.bar + 64 * j); sum += c; np += c ? 1u : 0u; if (j == (int)S.x) mine = c; }
                    if (sum == gridDim.x) { S.nx = mine; S.npop = np; break; }
                    __builtin_amdgcn_s_sleep(1);
                }
            }
            grid_seam(S);
        }
    }
}

extern "C" void kernel_launch(void* const* d_in, const int* in_sizes, int n_in, void* d_out, int out_size, void* d_ws, size_t ws_size, hipStream_t stream) {
    static int grid = 0;
    if (grid == 0) {
        int dev = 0, cus = 0, per_cu = 0;
        hipGetDevice(&dev);
        hipDeviceGetAttribute(&cus, hipDeviceAttributeMultiprocessorCount, dev);
        hipFuncSetAttribute((const void*)fwd_kernel, hipFuncAttributeMaxDynamicSharedMemorySize, LDS_BYTES);
        hipOccupancyMaxActiveBlocksPerMultiprocessor(&per_cu, (const void*)fwd_kernel, 512, LDS_BYTES);
        if (per_cu < 1) per_cu = 1;
        grid = cus * 1;
        (void)hipGetLastError();
    }
    Params p{};
    const float* const* in = (const float* const*)d_in;
    p.x = in[0]; p.mem = in[1]; p.g_norm = in[2]; p.g_mem = in[3]; p.w_in = in[4]; p.sinks = in[5]; p.w_sp = in[6]; p.b_sp = in[7]; p.g_sgu = in[8];
    p.w_pool = in[9]; p.pool_scale = in[10]; p.w_branch = in[11]; p.w_out = in[12]; p.w_q = in[13]; p.w_kv = in[14]; p.w_o = in[15]; p.w_up = in[16]; p.w_down = in[17];
    p.xres = (float*)d_out;
    unsigned char* ws = (unsigned char*)d_ws;
    size_t off = 0;
    auto take = [&](size_t bytes) { unsigned char* r = ws + off; off += (bytes + 255) & ~(size_t)255; return r; };
    p.W = (bf16_t*)take(W_TOTAL * 2);
    p.proj = (bf16_t*)take((size_t)T * IN_DIM * 2);
    p.Wkv = (bf16_t*)take((size_t)DEPTH * 1024 * 1024 * 2);
    p.ybr = (bf16_t*)take((size_t)T * 1536 * 2);
    p.merged = (bf16_t*)take((size_t)T * D * 2);
    p.xb = (bf16_t*)take((size_t)T * D * 2);
    p.kvm = (bf16_t*)take((size_t)DEPTH * NMEM_ROWS * 1024 * 2);
    p.memb = (bf16_t*)take((size_t)NMEM_ROWS * D * 2);
    p.rssq = (float*)take((size_t)T * 16 * 2);
    p.xs = (float*)take((size_t)T * 4);
    p.rmem = (float*)take((size_t)NMEM_ROWS * 4);
    p.xslot = (float*)take((size_t)T * 16);
    p.bar = (unsigned*)take(136 * 256 + (size_t)DEPTH * (IN_DIM + DFF) * 4);
    if (off > ws_size) { fprintf(stderr, "kernel_launch: workspace too small: need %zu have %zu\n", off, ws_size); return; }
    hipMemsetAsync(p.bar, 0, 136 * 256 + (size_t)DEPTH * (IN_DIM + DFF) * 4, stream);
    p.ph_lo = 0; p.ph_hi = N_PHASES;
    void* args[] = {&p};
    hipError_t e = hipLaunchCooperativeKernel((const void*)fwd_kernel, dim3(grid), dim3(512), args, LDS_BYTES, stream);
    if (e != hipSuccess) fprintf(stderr, "cooperative launch failed: %s (grid %d)\n", hipGetErrorString(e), grid);
}
```
